# Optimizing an MI355X kernel written in HIP

```python
import jax
import jax.numpy as jnp
from jax import lax
import numpy as np

D_MODEL = 1024
BATCH = 16
SEQ = 2048
DEPTH = 4

GRID_W = 64
CTX_LEN = 256
HEAD_DIM = 64
RWKV_HEADS = 4
ATTN_HEADS = 8
ATTN_KV_HEADS = 2
ATTN_GROUP = ATTN_HEADS // ATTN_KV_HEADS
MLSTM_HEADS = 4
C_R = RWKV_HEADS * HEAD_DIM
C_A = ATTN_HEADS * HEAD_DIM
C_KV = ATTN_KV_HEADS * HEAD_DIM
C_M = MLSTM_HEADS * HEAD_DIM
D_MIX = C_R + C_A + C_M
R_W = 64
R_A = 64
R_G = 128
RWKV_LORA = 2 * R_W + 2 * R_A + R_G
IN_SPLITS = (3 * C_R, RWKV_LORA, C_A + 2 * C_KV, 2 * C_M, 2 * C_M, 4 * MLSTM_HEADS)
N_IN = 3 * C_R + RWKV_LORA + C_A + 2 * C_KV + 4 * C_M + 4 * MLSTM_HEADS
D_FF = 4 * D_MODEL
CONV_W = 3
WINDOW = 128
ATTN_BLOCK = 128
MLSTM_CHUNK = 64
ROPE_BASE = 10000.0
ROPE_FREQS = HEAD_DIM // 4
HALF = HEAD_DIM // 2
DECAY_SCALE = 0.606531
RMS_EPS = 1e-6
RWKV_LN_EPS = 64e-5
MLSTM_LN_EPS = 1e-6
NEG_INF = -1e30

kernel_name = 'hybrid_rwkv7_swa_mlstm_dit_block'


def rms_norm(x, g):
    xf = x.astype(jnp.float32)
    y = xf * lax.rsqrt(jnp.mean(xf * xf, axis=-1, keepdims=True) + RMS_EPS)
    return (y * g.astype(jnp.float32)).astype(x.dtype)


def head_layernorm(y, w, eps):
    mu = jnp.mean(y, axis=-1, keepdims=True)
    yc = y - mu
    var = jnp.mean(yc * yc, axis=-1, keepdims=True)
    return yc * lax.rsqrt(var + eps) * w.astype(jnp.float32).reshape(y.shape[-2], y.shape[-1])


def split_heads(u):
    return u.reshape(u.shape[0], u.shape[1], -1, HEAD_DIM)


def centred_conv(u, w):
    half = CONV_W // 2
    length = u.shape[1]
    up = jnp.pad(u, ((0, 0), (half, half), (0, 0)))
    out = up[:, 0:length] * w[0]
    for j in range(1, CONV_W):
        out = out + up[:, j:j + length] * w[j]
    return out


def axial_rope(rows):
    row = jnp.repeat(jnp.arange(rows), GRID_W).astype(jnp.float32)
    col = jnp.tile(jnp.arange(GRID_W), rows).astype(jnp.float32)
    inv = ROPE_BASE ** (-jnp.arange(ROPE_FREQS, dtype=jnp.float32) / ROPE_FREQS)
    ang = jnp.concatenate([row[:, None] * inv, col[:, None] * inv], axis=-1)
    return jnp.cos(ang), jnp.sin(ang)


def apply_rope(u, cos, sin):
    shape = (1, cos.shape[0]) + (1,) * (u.ndim - 3) + (HALF,)
    cs = cos.reshape(shape)
    sn = sin.reshape(shape)
    u1 = u[..., :HALF]
    u2 = u[..., HALF:]
    return jnp.concatenate([u1 * cs - u2 * sn, u1 * sn + u2 * cs], axis=-1).astype(u.dtype)


def split_projection(p):
    points = [int(i) for i in np.cumsum(IN_SPLITS)[:-1]]
    return jnp.split(p, points, axis=-1)


def rwkv7_scan(s0, r, w, k, v, kk, b, reverse):
    xs = tuple(jnp.moveaxis(u, 1, 0) for u in (r, w, k, v, kk, b))

    def step(s, inp):
        r_t, w_t, k_t, v_t, kk_t, b_t = inp
        sa = jnp.einsum('bhvk,bhk->bhv', s, kk_t)
        s = s * w_t[:, :, None, :] - sa[..., None] * b_t[:, :, None, :] + v_t[..., None] * k_t[:, :, None, :]
        return s, jnp.einsum('bhvk,bhk->bhv', s, r_t)

    s_final, y = lax.scan(step, s0, xs, reverse=reverse)
    return s_final, jnp.moveaxis(y, 0, 1)


def rwkv_mixer(rkv_c, z_c, rkv_l, z_l, conv_w, w0, w_up, a0, a_up, g_up, k_k, k_a, r_k, ln_w, ln_b, need_ctx):
    out_dtype = rkv_l.dtype

    def prep(rkv, z):
        rkv = centred_conv(rkv, conv_w).astype(jnp.float32)
        r, k, v = jnp.split(rkv, 3, axis=-1)
        zw, za, zg = jnp.split(z.astype(jnp.float32), [2 * R_W, 2 * R_W + 2 * R_A], axis=-1)
        kk = split_heads(k * k_k)
        kk = kk * lax.rsqrt(jnp.sum(kk * kk, axis=-1, keepdims=True) + 1e-12)
        per_dir = []
        for d in range(2):
            dw = w0[d] + jnp.tanh(zw[..., d * R_W:(d + 1) * R_W]) @ w_up[d]
            w = jnp.exp(-DECAY_SCALE * jax.nn.sigmoid(dw))
            a = jax.nn.sigmoid(a0[d] + za[..., d * R_A:(d + 1) * R_A] @ a_up[d])
            k_dir = k * (1.0 + (a - 1.0) * k_a)
            per_dir.append((split_heads(w), split_heads(k_dir), kk * split_heads(a)))
        g = jax.nn.sigmoid(zg) @ g_up
        return split_heads(r), split_heads(k), split_heads(v), kk, g, per_dir

    r_c, k_c, v_c, kk_c, g_c, dir_c = prep(rkv_c, z_c)
    r_l, k_l, v_l, kk_l, g_l, dir_l = prep(rkv_l, z_l)
    s0 = jnp.zeros((r_l.shape[0], RWKV_HEADS, HEAD_DIM, HEAD_DIM), jnp.float32)
    y_c = 0.0
    y_l = 0.0
    for d in range(2):
        s_ctx, yc = rwkv7_scan(s0, r_c, dir_c[d][0], dir_c[d][1], v_c, kk_c, dir_c[d][2], d == 1)
        _, yl = rwkv7_scan(s_ctx, r_l, dir_l[d][0], dir_l[d][1], v_l, kk_l, dir_l[d][2], d == 1)
        y_c = y_c + yc
        y_l = y_l + yl

    def post(y, r, k, v, g):
        y = head_layernorm(y, ln_w, RWKV_LN_EPS) + ln_b.astype(jnp.float32).reshape(RWKV_HEADS, HEAD_DIM)
        bonus = jnp.sum(r * k * r_k.reshape(RWKV_HEADS, HEAD_DIM), axis=-1, keepdims=True) * v
        return ((y + bonus).reshape(y.shape[0], y.shape[1], C_R) * g).astype(out_dtype)

    out_c = post(y_c, r_c, k_c, v_c, g_c) if need_ctx else None
    return out_c, post(y_l, r_l, k_l, v_l, g_l)


def attention_mixer(qkv_c, qkv_l, sink, cos, sin, need_ctx):
    out_dtype = qkv_l.dtype
    scale = HEAD_DIM ** -0.5

    def heads(qkv):
        q, k, v = jnp.split(qkv, [C_A, C_A + C_KV], axis=-1)
        b, n = q.shape[:2]
        return (q.reshape(b, n, ATTN_KV_HEADS, ATTN_GROUP, HEAD_DIM),
                k.reshape(b, n, ATTN_KV_HEADS, HEAD_DIM),
                v.reshape(b, n, ATTN_KV_HEADS, HEAD_DIM))

    q_c, k_c, v_c = heads(qkv_c)
    q_l, k_l, v_l = heads(qkv_l)
    q_l = apply_rope(q_l, cos, sin)
    k_l = apply_rope(k_l, cos, sin)
    B, S = q_l.shape[:2]
    T = k_c.shape[1]
    nb = S // ATTN_BLOCK
    sink = sink.astype(jnp.float32).reshape(1, ATTN_KV_HEADS, ATTN_GROUP, 1, 1)

    pad = ((0, 0), (ATTN_BLOCK, ATTN_BLOCK), (0, 0), (0, 0))

    def band(u):
        u = jnp.pad(u, pad).reshape(B, nb + 2, ATTN_BLOCK, ATTN_KV_HEADS, HEAD_DIM)
        u = jnp.concatenate([u[:, :-2], u[:, 1:-1], u[:, 2:]], axis=2)
        return jnp.moveaxis(u, 1, 0)

    k_band = band(k_l)
    v_band = band(v_l)
    q_blk = jnp.moveaxis(q_l.reshape(B, nb, ATTN_BLOCK, ATTN_KV_HEADS, ATTN_GROUP, HEAD_DIM), 1, 0)
    blk = jnp.arange(nb)[:, None, None] * ATTN_BLOCK
    q_pos = blk + jnp.arange(ATTN_BLOCK)[None, :, None]
    k_pos = blk - ATTN_BLOCK + jnp.arange(3 * ATTN_BLOCK)[None, None, :]
    valid = (k_pos >= 0) & (k_pos < S) & (jnp.abs(k_pos - q_pos) <= WINDOW)
    sink_l = jnp.broadcast_to(sink, (B, ATTN_KV_HEADS, ATTN_GROUP, ATTN_BLOCK, 1))

    def block(args):
        q_i, k_i, v_i, m_i = args
        s_ctx = jnp.einsum('bqhgd,bkhd->bhgqk', q_i, k_c).astype(jnp.float32) * scale
        s_loc = jnp.einsum('bqhgd,bkhd->bhgqk', q_i, k_i).astype(jnp.float32) * scale
        s_loc = jnp.where(m_i, s_loc, NEG_INF)
        p = jax.nn.softmax(jnp.concatenate([sink_l, s_ctx, s_loc], axis=-1), axis=-1)
        o = jnp.einsum('bhgqk,bkhd->bqhgd', p[..., 1:1 + T].astype(v_c.dtype), v_c)
        return o + jnp.einsum('bhgqk,bkhd->bqhgd', p[..., 1 + T:].astype(v_i.dtype), v_i)

    y_l = jnp.moveaxis(lax.map(block, (q_blk, k_band, v_band, valid)), 0, 1).reshape(B, S, C_A)

    y_c = None
    if need_ctx:
        s = jnp.einsum('bqhgd,bkhd->bhgqk', q_c, k_c).astype(jnp.float32) * scale
        sink_c = jnp.broadcast_to(sink, (B, ATTN_KV_HEADS, ATTN_GROUP, T, 1))
        p = jax.nn.softmax(jnp.concatenate([sink_c, s], axis=-1), axis=-1)[..., 1:]
        y_c = jnp.einsum('bhgqk,bkhd->bqhgd', p.astype(v_c.dtype), v_c).reshape(B, T, C_A).astype(out_dtype)
    return y_c, y_l.astype(out_dtype)


def mlstm_chunkwise(state, q, k, v, ig, lf):
    B, H, L, N = q.shape
    nc = L // MLSTM_CHUNK

    def chunks(u):
        u = u.reshape((B, H, nc, MLSTM_CHUNK) + u.shape[3:])
        return jnp.moveaxis(u, 2, 0)

    tri = jnp.tril(jnp.ones((MLSTM_CHUNK, MLSTM_CHUNK), bool))

    def step(carry, inp):
        C, n, m = carry
        q_c, k_c, v_c, i_c, f_c = inp
        b = jnp.cumsum(f_c, axis=-1)
        logd = jnp.where(tri, b[..., :, None] - b[..., None, :] + i_c[..., None, :], NEG_INF)
        inter = b + m[..., None]
        m_t = jnp.maximum(inter, jnp.max(logd, axis=-1))
        w_intra = jnp.exp(logd - m_t[..., None])
        w_inter = jnp.exp(inter - m_t)
        s = jnp.einsum('bhtd,bhsd->bhts', q_c, k_c) * w_intra
        num = jnp.einsum('bhts,bhsd->bhtd', s, v_c) + w_inter[..., None] * jnp.einsum('bhvk,bhtk->bhtv', C, q_c)
        den = jnp.sum(s, axis=-1) + w_inter * jnp.einsum('bhk,bhtk->bht', n, q_c)
        h = num / jnp.maximum(jnp.abs(den), jnp.exp(-m_t))[..., None]
        b_end = b[..., -1]
        g = b_end[..., None] - b + i_c
        m_new = jnp.maximum(b_end + m, jnp.max(g, axis=-1))
        gw = jnp.exp(g - m_new[..., None])
        dec = jnp.exp(b_end + m - m_new)
        C = dec[..., None, None] * C + jnp.einsum('bhs,bhsv,bhsk->bhvk', gw, v_c, k_c)
        n = dec[..., None] * n + jnp.einsum('bhs,bhsk->bhk', gw, k_c)
        return (C, n, m_new), h

    carry, h = lax.scan(step, state, tuple(chunks(u) for u in (q, k, v, ig, lf)))
    h = jnp.moveaxis(h, 0, 2).reshape(B, H, L, N)
    return carry, h


def mlstm_mixer(qk_c, vo_c, gt_c, qk_l, vo_l, gt_l, conv_w, b_i, b_f, norm_g, need_ctx):
    out_dtype = qk_l.dtype

    def to_bhln(u):
        return jnp.swapaxes(split_heads(u), 1, 2)

    def prep(qk, vo, gt):
        qk = jax.nn.silu(centred_conv(qk, conv_w).astype(jnp.float32))
        q, k = jnp.split(qk, 2, axis=-1)
        v, o = jnp.split(vo.astype(jnp.float32), 2, axis=-1)
        zi, zf = jnp.split(gt.astype(jnp.float32), 2, axis=-1)
        return to_bhln(q), to_bhln(k) * HEAD_DIM ** -0.5, to_bhln(v), o, zi, zf

    q_c, k_c, v_c, o_c, zi_c, zf_c = prep(qk_c, vo_c, gt_c)
    q_l, k_l, v_l, o_l, zi_l, zf_l = prep(qk_l, vo_l, gt_l)
    B = q_l.shape[0]
    zero = (jnp.zeros((B, MLSTM_HEADS, HEAD_DIM, HEAD_DIM), jnp.float32),
            jnp.zeros((B, MLSTM_HEADS, HEAD_DIM), jnp.float32),
            jnp.zeros((B, MLSTM_HEADS), jnp.float32))
    h_c = 0.0
    h_l = 0.0
    for d in range(2):
        sl = slice(d * MLSTM_HEADS, (d + 1) * MLSTM_HEADS)
        i_c = jnp.swapaxes(zi_c[..., sl] + b_i[d], 1, 2)
        f_c = jax.nn.log_sigmoid(jnp.swapaxes(zf_c[..., sl] + b_f[d], 1, 2))
        i_l = jnp.swapaxes(zi_l[..., sl] + b_i[d], 1, 2)
        f_l = jax.nn.log_sigmoid(jnp.swapaxes(zf_l[..., sl] + b_f[d], 1, 2))
        if d == 1:
            seq_c = [jnp.flip(u, 2) for u in (q_c, k_c, v_c, i_c, f_c)]
            seq_l = [jnp.flip(u, 2) for u in (q_l, k_l, v_l, i_l, f_l)]
        else:
            seq_c = [q_c, k_c, v_c, i_c, f_c]
            seq_l = [q_l, k_l, v_l, i_l, f_l]
        state_c, hc = mlstm_chunkwise(zero, *seq_c)
        _, hl = mlstm_chunkwise(state_c, *seq_l)
        if d == 1:
            hc = jnp.flip(hc, 2)
            hl = jnp.flip(hl, 2)
        h_c = h_c + hc
        h_l = h_l + hl

    def post(h, o):
        h = head_layernorm(jnp.swapaxes(h, 1, 2), norm_g, MLSTM_LN_EPS)
        return (jax.nn.sigmoid(o) * h.reshape(h.shape[0], h.shape[1], C_M)).astype(out_dtype)

    out_c = post(h_c, o_c) if need_ctx else None
    return out_c, post(h_l, o_l)


def sq_relu_mlp(h, w1, w2):
    return jnp.square(jax.nn.relu(h @ w1)) @ w2


def setup_inputs(seed: int = 0) -> dict:
    key = jax.random.key(seed)
    ks = iter(jax.random.split(key, 32))
    f32 = jnp.float32

    def nrm(shape, scale=1.0):
        return jax.random.normal(next(ks), shape, f32) * scale

    L = DEPTH
    D = D_MODEL
    centre = jnp.zeros((CONV_W, 1), f32).at[CONV_W // 2].set(1.0)
    return {
        'x': nrm((BATCH, SEQ, D)),
        'c': nrm((BATCH, D)),
        'ctx': nrm((BATCH, CTX_LEN, D)),
        'c_ctx': nrm((D,)),
        'ada_w': nrm((L, D, 6 * D), 0.5 * D ** -0.5),
        'ada_b': nrm((L, 6 * D), 0.02),
        'norm1_g': 1.0 + nrm((L, D), 0.02),
        'norm2_g': 1.0 + nrm((L, D), 0.02),
        'w_in': nrm((L, D, N_IN), D ** -0.5),
        'w_out': nrm((L, D_MIX, D), D_MIX ** -0.5),
        'rwkv_conv': centre + nrm((L, CONV_W, 3 * C_R), 0.2),
        'rwkv_w0': nrm((L, 2, C_R), 1.0),
        'rwkv_w_up': nrm((L, 2, R_W, C_R), R_W ** -0.5),
        'rwkv_a0': nrm((L, 2, C_R), 0.5),
        'rwkv_a_up': nrm((L, 2, R_A, C_R), 0.5 * R_A ** -0.5),
        'rwkv_g_up': nrm((L, R_G, C_R), R_G ** -0.5),
        'rwkv_k_k': 1.0 + nrm((L, C_R), 0.1),
        'rwkv_k_a': 1.0 + nrm((L, C_R), 0.1),
        'rwkv_r_k': nrm((L, C_R), 0.1),
        'rwkv_ln_w': 1.0 + nrm((L, C_R), 0.02),
        'rwkv_ln_b': nrm((L, C_R), 0.02),
        'attn_sink': nrm((L, ATTN_HEADS), 0.5),
        'mlstm_conv': centre + nrm((L, CONV_W, 2 * C_M), 0.2),
        'mlstm_b_i': nrm((L, 2, MLSTM_HEADS), 0.1),
        'mlstm_b_f': jnp.linspace(3.0, 6.0, MLSTM_HEADS, dtype=f32) + nrm((L, 2, MLSTM_HEADS), 0.1),
        'mlstm_norm_g': 1.0 + nrm((L, C_M), 0.02),
        'mlp_w1': nrm((L, D, D_FF), D ** -0.5),
        'mlp_w2': nrm((L, D_FF, D), D_FF ** -0.5),
        'final_g': 1.0 + nrm((D,), 0.02),
    }


def reference(x, c, ctx, c_ctx, ada_w, ada_b, norm1_g, norm2_g, w_in, w_out,
              rwkv_conv, rwkv_w0, rwkv_w_up, rwkv_a0, rwkv_a_up, rwkv_g_up,
              rwkv_k_k, rwkv_k_a, rwkv_r_k, rwkv_ln_w, rwkv_ln_b,
              attn_sink, mlstm_conv, mlstm_b_i, mlstm_b_f, mlstm_norm_g,
              mlp_w1, mlp_w2, final_g):
    S = x.shape[1]
    rows = S // GRID_W
    cos, sin = axial_rope(rows)
    x_l = x
    x_c = ctx
    silu_c = jax.nn.silu(c)
    silu_cc = jax.nn.silu(c_ctx)[None, :]
    for l in range(DEPTH):
        need_ctx = l < DEPTH - 1
        mod_l = jnp.split((silu_c @ ada_w[l] + ada_b[l])[:, None, :], 6, axis=-1)
        mod_c = jnp.split((silu_cc @ ada_w[l] + ada_b[l])[:, None, :], 6, axis=-1)
        h_l = rms_norm(x_l, norm1_g[l]) * (1.0 + mod_l[1]) + mod_l[0]
        h_c = rms_norm(x_c, norm1_g[l]) * (1.0 + mod_c[1]) + mod_c[0]
        p_l = split_projection(h_l @ w_in[l])
        p_c = split_projection(h_c @ w_in[l])
        yr_c, yr_l = rwkv_mixer(p_c[0], p_c[1], p_l[0], p_l[1], rwkv_conv[l], rwkv_w0[l], rwkv_w_up[l],
                                rwkv_a0[l], rwkv_a_up[l], rwkv_g_up[l], rwkv_k_k[l], rwkv_k_a[l],
                                rwkv_r_k[l], rwkv_ln_w[l], rwkv_ln_b[l], need_ctx)
        ya_c, ya_l = attention_mixer(p_c[2], p_l[2], attn_sink[l], cos, sin, need_ctx)
        ym_c, ym_l = mlstm_mixer(p_c[3], p_c[4], p_c[5], p_l[3], p_l[4], p_l[5], mlstm_conv[l],
                                 mlstm_b_i[l], mlstm_b_f[l], mlstm_norm_g[l], need_ctx)
        x_l = x_l + mod_l[2] * (jnp.concatenate([yr_l, ya_l, ym_l], axis=-1) @ w_out[l])
        x_l = x_l + mod_l[5] * sq_relu_mlp(rms_norm(x_l, norm2_g[l]) * (1.0 + mod_l[4]) + mod_l[3],
                                           mlp_w1[l], mlp_w2[l])
        if need_ctx:
            x_c = x_c + mod_c[2] * (jnp.concatenate([yr_c, ya_c, ym_c], axis=-1) @ w_out[l])
            x_c = x_c + mod_c[5] * sq_relu_mlp(rms_norm(x_c, norm2_g[l]) * (1.0 + mod_c[4]) + mod_c[3],
                                               mlp_w1[l], mlp_w2[l])
    return rms_norm(x_l, final_g)
```

```cpp
#include <hip/hip_runtime.h>
#include <hip/hip_cooperative_groups.h>
#include <cstdio>
#include <cstdint>
namespace cg = cooperative_groups;

__device__ __forceinline__ int opaque_tid() { int t = threadIdx.x; asm volatile("" : "+v"(t)); return t; }
namespace pg8 {
#define PG8_LAS __attribute__((address_space(3)))
typedef unsigned short bf16_t;
typedef short bf16x8 __attribute__((ext_vector_type(8)));
typedef float f32x4 __attribute__((ext_vector_type(4)));
typedef unsigned u32x4 __attribute__((ext_vector_type(4)));
constexpr int BM = 256, BK = 64, HALF = 128, HTB = HALF * BK * 2  , STAGE_BYTES = 8 * HTB, NXCD = 8, WGM = 8;

__host__ __device__ __forceinline__ int lds_byte(int r, int c) { const int st = (r >> 4) * 2 + (c >> 5), rr = r & 15, cc = c & 31, ob = rr * 64 + cc * 2; return st * 1024 + (ob ^ (((ob >> 9) & 1) << 5)); }
__host__ __device__ __forceinline__ void stage_rc(int b, int& R, int& C) { const int st = b / 1024, sb = b % 1024, swz = sb ^ (((sb >> 9) & 1) << 5); R = (st >> 1) * 16 + swz / 64; C = (st & 1) * 32 + (swz % 64) / 2; }
__host__ __device__ __forceinline__ int perm32(int rho) { const int n = rho >> 4, i = rho & 15; return 8 * (i >> 2) + 4 * n + (i & 3); }

struct Unit { int pm, pn; };
struct Gemm { const bf16_t* A; const bf16_t* Bt; int M, N, K; };

struct StaticOrder {
    int nM, nN, nwg, G, c;
    __host__ __device__ void init(int M, int N, int G_, int c_) { nM = M / BM; nN = N / BM; nwg = nM * nN; G = G_; c = c_; }
    __host__ __device__ bool next(int i, Unit& u) const {
        const long L = (long)i * G + c; if (L >= nwg) return false;
        int wgid = (int)L; { const int q = nwg / NXCD, r = nwg % NXCD, xcd = wgid % NXCD, off = wgid / NXCD; wgid = (xcd < r ? xcd * (q + 1) : r * (q + 1) + (xcd - r) * q) + off; }
        const int nig = WGM * nN, gid = wgid / nig, fm = gid * WGM, gsz = (nM - fm) < WGM ? (nM - fm) : WGM;
        u.pm = fm + ((wgid % nig) % gsz); u.pn = (wgid % nig) / gsz; return true;
    }
    __device__ __forceinline__ void a_ready(const Unit&) const {}
    __device__ __forceinline__ void done(const Unit&) const {}
};

template <class Epi, class Sched, bool STAMP = false>
__device__ __forceinline__ void gemm_phase(PG8_LAS unsigned char* lds, const Gemm g, const Sched& S, const Epi& E, unsigned long long* stamps) {
    const int tid = opaque_tid(), wid = __builtin_amdgcn_readfirstlane(tid >> 6), lane = tid & 63, wr = wid >> 2, wc = wid & 3, fr = lane & 15, fq = lane >> 4;
    const int K = g.K, nt = K / BK;
    int ts_lo = 0, ts_hi = 0, nts = 0; const unsigned long long rt_entry = STAMP ? (unsigned long long)wall_clock64() : 0ull;
#define PG8_STAMP() do { if (STAMP && wid == 0 && nts < 64) { const unsigned long long _c = (unsigned long long)clock64(); \
        ts_lo = (lane == nts) ? (int)(unsigned)_c : ts_lo; ts_hi = (lane == nts) ? (int)(unsigned)(_c >> 32) : ts_hi; ++nts; } } while (0)
    PG8_STAMP();
    unsigned voffA[2], voffB[2];
#pragma unroll
    for (int i = 0; i < 2; ++i) { int R, C; stage_rc(tid * 16 + i * 8192, R, C); const int Rb = Epi::PERM ? ((R & ~31) + perm32(R & 31)) : R;
        voffA[i] = (unsigned)(R * K + C) * 2u; voffB[i] = (unsigned)(Rb * K + C) * 2u; }
    const size_t kstep = (size_t)(BK * 2);
    const size_t hstep = (size_t)HALF * K * 2;
    const size_t tstep = 2 * hstep;
    const unsigned ldsw = (unsigned)wid * 1024u;
    const int aoff = lds_byte(wr * 64 + fr, fq * 8), boff = lds_byte(wc * 32 + fr, fq * 8);
#define PG8_SA(b, h) (((b) * 2 + (h)) * HTB)
#define PG8_SB(b, h) ((4 + (b) * 2 + (h)) * HTB)
#define PG8_STAGE(bufoff, gbase, voff) do { _Pragma("unroll") for (int _i = 0; _i < 2; ++_i) \
        __builtin_amdgcn_global_load_lds((const unsigned*)((const char*)(gbase) + (voff)[_i]), (PG8_LAS unsigned*)(lds + (bufoff) + ldsw + _i * 8192), 16, 0, 0); } while (0)
#define PG8_LDA(dst, b, h) do { _Pragma("unroll") for (int m = 0; m < 4; ++m) _Pragma("unroll") for (int k = 0; k < 2; ++k) dst[m][k] = *(const PG8_LAS bf16x8*)(lds + PG8_SA(b, h) + aoff + m * 2048 + k * 1024); } while (0)
#define PG8_LDB(dst, b, h) do { _Pragma("unroll") for (int n = 0; n < 2; ++n) _Pragma("unroll") for (int k = 0; k < 2; ++k) dst[n][k] = *(const PG8_LAS bf16x8*)(lds + PG8_SB(b, h) + boff + n * 2048 + k * 1024); } while (0)
#define PG8_MMA(ai, bj, At, Bt) do { __builtin_amdgcn_s_setprio(1); _Pragma("unroll") for (int m = 0; m < 4; ++m) _Pragma("unroll") for (int n = 0; n < 2; ++n) _Pragma("unroll") for (int k = 0; k < 2; ++k) \
        acc[ai][bj][m][n] = __builtin_amdgcn_mfma_f32_16x16x32_bf16(Bt[n][k], At[m][k], acc[ai][bj][m][n], 0, 0, 0); __builtin_amdgcn_s_setprio(0); } while (0)
#define PG8_WAIT_V(n) asm volatile("s_waitcnt vmcnt(" #n ")" ::: "memory")
#define PG8_WAIT_L(n) asm volatile("s_waitcnt lgkmcnt(" #n ")" ::: "memory")
#define PG8_BAR __builtin_amdgcn_s_barrier()
#define PG8_SCHED __builtin_amdgcn_sched_barrier(0)
    Unit cur, nxt; int ui = 0;
    if (!S.next(0, cur)) return;
    f32x4 acc[2][2][4][2];
#pragma unroll
    for (int a = 0; a < 2; ++a)
#pragma unroll
        for (int b = 0; b < 2; ++b)
#pragma unroll
            for (int m = 0; m < 4; ++m)
#pragma unroll
                for (int n = 0; n < 2; ++n) acc[a][b][m][n] = (f32x4){0.f, 0.f, 0.f, 0.f};
    bf16x8 At[4][2], B0[2][2], B1[2][2];
    const char* cA = (const char*)g.A + (size_t)cur.pm * tstep; const char* cB = (const char*)g.Bt + (size_t)cur.pn * tstep;
    S.a_ready(cur);
    PG8_STAGE(PG8_SB(0, 0), cB, voffB); PG8_STAGE(PG8_SA(0, 0), cA, voffA); PG8_STAGE(PG8_SB(0, 1), cB + hstep, voffB); PG8_STAGE(PG8_SA(0, 1), cA + hstep, voffA);
    if (wr == 1) PG8_BAR;
    PG8_WAIT_V(4); PG8_BAR;
    PG8_STAGE(PG8_SB(1, 0), cB + kstep, voffB); PG8_STAGE(PG8_SA(1, 0), cA + kstep, voffA); PG8_STAGE(PG8_SB(1, 1), cB + hstep + kstep, voffB);
    PG8_WAIT_V(6); PG8_BAR;
    PG8_STAMP();
    for (;;) {
        const bool has_next = S.next(ui + 1, nxt);
        const char* nA = has_next ? (const char*)g.A + (size_t)nxt.pm * tstep : cA; const char* nB = has_next ? (const char*)g.Bt + (size_t)nxt.pn * tstep : cB;
        for (int t = 0; t < nt; t += 2) {
            const bool last = (t == nt - 2);
            const char* a1 = cA + (size_t)(t + 1) * kstep;
            const char* a2 = last ? nA : cA + (size_t)(t + 2) * kstep; const char* b2 = last ? nB : cB + (size_t)(t + 2) * kstep;
            const char* a3 = a2 + kstep; const char* b3 = b2 + kstep;
            if (last && has_next) S.a_ready(nxt);
            PG8_LDB(B0, 0, 0); PG8_SCHED; PG8_LDA(At, 0, 0); PG8_STAGE(PG8_SA(1, 1), a1 + hstep, voffA);
            PG8_WAIT_L(8); PG8_BAR; PG8_WAIT_L(0); PG8_MMA(0, 0, At, B0); PG8_BAR; PG8_SCHED;
            PG8_LDB(B1, 0, 1); PG8_STAGE(PG8_SB(0, 0), b2, voffB);
            PG8_BAR; PG8_WAIT_L(0); PG8_MMA(0, 1, At, B1); PG8_BAR;
            PG8_LDA(At, 0, 1); PG8_STAGE(PG8_SA(0, 0), a2, voffA);
            PG8_BAR; PG8_WAIT_L(0); PG8_MMA(1, 0, At, B0); PG8_BAR; PG8_SCHED;
            PG8_STAGE(PG8_SB(0, 1), b2 + hstep, voffB);
            PG8_WAIT_V(6); PG8_BAR; PG8_MMA(1, 1, At, B1); PG8_BAR;
            PG8_LDB(B0, 1, 0); PG8_SCHED; PG8_LDA(At, 1, 0); PG8_STAGE(PG8_SA(0, 1), a2 + hstep, voffA);
            PG8_WAIT_L(8); PG8_BAR; PG8_WAIT_L(0); PG8_MMA(0, 0, At, B0); PG8_BAR; PG8_SCHED;
            PG8_LDB(B1, 1, 1); PG8_STAGE(PG8_SB(1, 0), b3, voffB);
            PG8_BAR; PG8_WAIT_L(0); PG8_MMA(0, 1, At, B1); PG8_BAR;
            PG8_LDA(At, 1, 1); PG8_STAGE(PG8_SA(1, 0), a3, voffA);
            PG8_BAR; PG8_WAIT_L(0); PG8_MMA(1, 0, At, B0); PG8_BAR; PG8_SCHED;
            PG8_STAGE(PG8_SB(1, 1), b3 + hstep, voffB);
            PG8_WAIT_V(6); PG8_BAR; PG8_MMA(1, 1, At, B1); PG8_BAR;
        }
        PG8_STAMP();
        if constexpr (!Epi::AFTER_DRAIN) { E(acc, cur, wr, wc, fr, fq); S.done(cur); }
        PG8_STAMP();
        if (!has_next) break;
#pragma unroll
        for (int a = 0; a < 2; ++a)
#pragma unroll
            for (int b = 0; b < 2; ++b)
#pragma unroll
                for (int m = 0; m < 4; ++m)
#pragma unroll
                    for (int n = 0; n < 2; ++n) acc[a][b][m][n] = (f32x4){0.f, 0.f, 0.f, 0.f};
        cur = nxt; cA = nA; cB = nB; ++ui;
    }
    PG8_WAIT_V(0);
    if (wr == 0) PG8_BAR;
    PG8_BAR;
    if constexpr (Epi::AFTER_DRAIN) { E.fused(acc, cur, wr, wc, fr, fq, lds, wid, lane); S.done(cur); }
    PG8_STAMP();
    if (STAMP && wid == 0) { stamps[lane] = lane < nts ? (((unsigned long long)(unsigned)ts_hi << 32) | (unsigned)ts_lo) : 0ull;
        if (lane == 62) stamps[62] = rt_entry; if (lane == 63) stamps[63] = (unsigned long long)wall_clock64(); }
#undef PG8_STAMP
#undef PG8_SA
#undef PG8_SB
#undef PG8_STAGE
#undef PG8_LDA
#undef PG8_LDB
#undef PG8_MMA
#undef PG8_WAIT_V
#undef PG8_WAIT_L
#undef PG8_BAR
#undef PG8_SCHED
}
}


#define LAS __attribute__((address_space(3)))
typedef unsigned short bf16_t;
typedef short bf16x8 __attribute__((ext_vector_type(8)));
typedef float f32x4 __attribute__((ext_vector_type(4)));
typedef unsigned u32x4 __attribute__((ext_vector_type(4)));
typedef unsigned u32x2 __attribute__((ext_vector_type(2)));

constexpr int D = 1024, NB = 16, SEQ = 2048, TC = 256, DEPTH = 4;
constexpr int MC = NB * TC, ML = NB * SEQ, M = MC + ML;
constexpr int NIN = 2960, NINP = 3072, P1W = 1152, P2W = 1808, DFF = 4096;
constexpr int NT = 512;
constexpr int LDS_BYTES = 132096;

constexpr size_t WS_MOD = 0;
constexpr size_t WS_ROPE = WS_MOD + 2097152;
constexpr size_t WS_XC = WS_ROPE + 524288;
constexpr size_t WS_WIN = WS_XC + (size_t)MC * D * 4;
constexpr size_t WS_WOUT = WS_WIN + (size_t)NINP * D * 2;
constexpr size_t WS_W1 = WS_WOUT + (size_t)D * D * 2;
constexpr size_t WS_W2 = WS_W1 + (size_t)DFF * D * 2;
constexpr size_t WS_H = WS_W2 + (size_t)DFF * D * 2;
constexpr size_t WS_P1 = WS_H + (size_t)M * D * 2;
constexpr size_t WS_P2 = WS_P1 + (size_t)M * P1W * 2;
constexpr size_t WS_RKV = WS_P2 + (size_t)M * P2W * 2;
constexpr size_t WS_WD = WS_RKV + (size_t)M * 768 * 2;
constexpr size_t WS_AD = WS_WD + (size_t)2 * M * 256 * 2;
constexpr size_t WS_G = WS_AD + (size_t)2 * M * 256 * 2;
constexpr size_t WS_YM = WS_G + (size_t)M * 256 * 2;
constexpr size_t WS_END = WS_YM + (size_t)2 * M * 256 * 2;
static_assert(WS_END <= 536870912ull, "workspace map exceeds 512 MiB");
static_assert(WS_P1 + (size_t)M * DFF * 2 <= WS_AD, "hidden overlay must end inside the dead mixer buffers");

struct Params { const float* in[29]; float* out; unsigned char* ws; int ph_lo, ph_hi; };
enum { I_X = 0, I_C, I_CTX, I_CCTX, I_ADAW, I_ADAB, I_N1G, I_N2G, I_WIN, I_WOUT, I_RCONV, I_RW0, I_RWUP, I_RA0, I_RAUP, I_RGUP, I_RKK, I_RKA, I_RRK, I_RLNW, I_RLNB,
       I_SINK, I_MCONV, I_MBI, I_MBF, I_MNG, I_W1, I_W2, I_FG };

__device__ __forceinline__ unsigned f2bf(float f) { unsigned u = __builtin_bit_cast(unsigned, f); return (u + 0x7fffu + ((u >> 16) & 1u)) >> 16; }
__device__ __forceinline__ float bf2f(unsigned b) { return __builtin_bit_cast(float, (b & 0xffffu) << 16); }
__device__ __forceinline__ float bflo(unsigned w) { return __builtin_bit_cast(float, w << 16); }
__device__ __forceinline__ float bfhi(unsigned w) { return __builtin_bit_cast(float, w & 0xffff0000u); }
__device__ __forceinline__ unsigned pk2(float lo, float hi) { return f2bf(lo) | (f2bf(hi) << 16); }
__device__ __forceinline__ float sigmoidf_(float x) { return 1.f / (1.f + __expf(-x)); }
__device__ __forceinline__ float wave_sum(float v) {
#pragma unroll
    for (int o = 1; o < 64; o <<= 1) v += __shfl_xor(v, o);
    return v;
}
#define LDS_WAIT() asm volatile("s_waitcnt lgkmcnt(0)" ::: "memory")
__device__ __forceinline__ void unpack8(const u32x4 w, float (&f)[8]) {
    f[0] = bflo(w.x); f[1] = bfhi(w.x); f[2] = bflo(w.y); f[3] = bfhi(w.y); f[4] = bflo(w.z); f[5] = bfhi(w.z); f[6] = bflo(w.w); f[7] = bfhi(w.w);
}
__device__ __forceinline__ u32x4 pack8(const float (&f)[8]) { u32x4 o; o.x = pk2(f[0], f[1]); o.y = pk2(f[2], f[3]); o.z = pk2(f[4], f[5]); o.w = pk2(f[6], f[7]); return o; }
__device__ __forceinline__ float h2f(unsigned bits) { return (float)__builtin_bit_cast(_Float16, (unsigned short)bits); }
__device__ __forceinline__ unsigned f2h(float f) { return (unsigned)__builtin_bit_cast(unsigned short, (_Float16)f); }

__device__ __forceinline__ int chain_row(int b, int dir, int n) {
    if (n < TC) { const int t = dir ? (TC - 1 - n) : n; return b * TC + t; }
    int s = n - TC; s = dir ? (SEQ - 1 - s) : s; return MC + b * SEQ + s;
}

struct EpiIn {
    static constexpr bool PERM = false, AFTER_DRAIN = false;
    bf16_t* P1; bf16_t* P2;
    __device__ __forceinline__ void operator()(const f32x4 (&acc)[2][2][4][2], const pg8::Unit& u, int wr, int wc, int fr, int fq) const {
        const int row0 = u.pm * 256 + wr * 64 + fr, col0 = u.pn * 256 + wc * 32 + 4 * fq;
#pragma unroll
        for (int ai = 0; ai < 2; ++ai)
#pragma unroll
            for (int m = 0; m < 4; ++m) { const size_t row = (size_t)(row0 + ai * 128 + m * 16);
#pragma unroll
                for (int bj = 0; bj < 2; ++bj)
#pragma unroll
                    for (int n = 0; n < 2; ++n) { const int col = col0 + bj * 128 + n * 16; const f32x4 v = acc[ai][bj][m][n];
                        u32x2 o; o.x = pk2(v[0], v[1]); o.y = pk2(v[2], v[3]);
                        if (col < P1W) *(u32x2*)(P1 + row * P1W + col) = o;
                        else if (col < NIN) *(u32x2*)(P2 + row * P2W + (col - P1W)) = o; } }
    }
};
struct EpiRes {
    static constexpr bool PERM = false, AFTER_DRAIN = false;
    float* Xc; float* Xl; const float* modl; int gate_idx; int row_off;
    __device__ __forceinline__ void operator()(const f32x4 (&acc)[2][2][4][2], const pg8::Unit& u, int wr, int wc, int fr, int fq) const {
        const int row0 = row_off + u.pm * 256 + wr * 64 + fr, col0 = u.pn * 256 + wc * 32 + 4 * fq;
#pragma unroll
        for (int ai = 0; ai < 2; ++ai)
#pragma unroll
            for (int m = 0; m < 4; ++m) { const int row = row0 + ai * 128 + m * 16;
                const int bi = row < MC ? 16 : ((row - MC) >> 11);
                float* xp = row < MC ? Xc + (size_t)row * D : Xl + (size_t)(row - MC) * D;
                const float* gp = modl + (size_t)bi * 6144 + gate_idx * 1024;
#pragma unroll
                for (int bj = 0; bj < 2; ++bj)
#pragma unroll
                    for (int n = 0; n < 2; ++n) { const int col = col0 + bj * 128 + n * 16;
                        const f32x4 g = *(const f32x4*)(gp + col); f32x4 x = *(f32x4*)(xp + col);
                        x = x + g * acc[ai][bj][m][n]; *(f32x4*)(xp + col) = x; } }
    }
};
struct EpiSq {
    static constexpr bool PERM = false, AFTER_DRAIN = false;
    bf16_t* Hd;
    __device__ __forceinline__ void operator()(const f32x4 (&acc)[2][2][4][2], const pg8::Unit& u, int wr, int wc, int fr, int fq) const {
        const int row0 = u.pm * 256 + wr * 64 + fr, col0 = u.pn * 256 + wc * 32 + 4 * fq;
#pragma unroll
        for (int ai = 0; ai < 2; ++ai)
#pragma unroll
            for (int m = 0; m < 4; ++m) { bf16_t* rp = Hd + (size_t)(row0 + ai * 128 + m * 16) * DFF + col0;
#pragma unroll
                for (int bj = 0; bj < 2; ++bj)
#pragma unroll
                    for (int n = 0; n < 2; ++n) { f32x4 v = acc[ai][bj][m][n];
#pragma unroll
                        for (int j = 0; j < 4; ++j) { const float r = v[j] > 0.f ? v[j] : 0.f; v[j] = r * r; }
                        u32x2 o; o.x = pk2(v[0], v[1]); o.y = pk2(v[2], v[3]); *(u32x2*)(rp + bj * 128 + n * 16) = o; } }
    }
};

__device__ __forceinline__ void phase_adaln(const Params& p, LAS unsigned char* lds, int bid, int G) {
    const int tid = opaque_tid(), wave = tid >> 6, lane = tid & 63;
    LAS float* sc = (LAS float*)lds;
    LAS float* red = sc + 17 * 1024;
    float* MOD = (float*)(p.ws + WS_MOD);
    for (int i = tid; i < 17 * 1024; i += NT) { const int bi = i >> 10, k = i & 1023; const float c = bi < 16 ? p.in[I_C][bi * 1024 + k] : p.in[I_CCTX][k]; sc[i] = c * sigmoidf_(c); }
    __syncthreads();
    for (int item = bid; item < 384; item += G) {
        const int l = item / 96, j0 = (item % 96) * 64;
        float acc[17];
#pragma unroll
        for (int bi = 0; bi < 17; ++bi) acc[bi] = 0.f;
        const float* w = p.in[I_ADAW] + ((size_t)l * 1024 + wave * 128) * 6144 + j0 + lane;
#pragma unroll 4
        for (int kk = 0; kk < 128; ++kk) { const float a = w[(size_t)kk * 6144]; const int k = wave * 128 + kk;
#pragma unroll
            for (int bi = 0; bi < 17; ++bi) acc[bi] += sc[bi * 1024 + k] * a; }
#pragma unroll
        for (int bi = 0; bi < 17; ++bi) red[(wave * 17 + bi) * 64 + lane] = acc[bi];
        __syncthreads();
        for (int i = tid; i < 17 * 64; i += NT) { const int bi = i >> 6, ln = i & 63; float s = 0.f;
#pragma unroll
            for (int w8 = 0; w8 < 8; ++w8) s += red[(w8 * 17 + bi) * 64 + ln];
            MOD[((size_t)l * 17 + bi) * 6144 + j0 + ln] = s + p.in[I_ADAB][l * 6144 + j0 + ln]; }
        __syncthreads();
    }
    float* ROPE = (float*)(p.ws + WS_ROPE);
    for (int idx = bid * NT + tid; idx < SEQ * 32; idx += G * NT) { const int pos = idx >> 5, i = idx & 31, f = i & 15;
        const float inv = powf(10000.f, -(float)f / 16.f); const float ang = (float)(i < 16 ? (pos >> 6) : (pos & 63)) * inv;
        const float n = rintf(ang * 0.15915494309189535f); float r = fmaf(-n, 6.28318548202514648f, ang); r = fmaf(-n, -1.7484555e-7f, r);
        ROPE[2 * idx] = cosf(r); ROPE[2 * idx + 1] = sinf(r); }
}

__device__ __forceinline__ void transpose_item(const float* W, int K, int N, bf16_t* WT, LAS float* scr, int item, int lane) {
    const int nblk = (N + 31) / 32, kb = item / nblk, nb = item % nblk, k0 = 64 * kb, n0 = 32 * nb;
    const int nn = n0 + (lane & 31); const bool ok = nn < N;
#pragma unroll 8
    for (int i = 0; i < 32; ++i) { const int kk = 2 * i + (lane >> 5); scr[kk * 33 + (lane & 31)] = ok ? W[(size_t)(k0 + kk) * N + nn] : 0.f; }
    LDS_WAIT();
    const int c = lane & 7;
#pragma unroll
    for (int j = 0; j < 4; ++j) { const int n = (lane >> 3) + 8 * j; const LAS float* s = scr + (8 * c) * 33 + n;
        u32x4 o; o.x = pk2(s[0 * 33], s[1 * 33]); o.y = pk2(s[2 * 33], s[3 * 33]); o.z = pk2(s[4 * 33], s[5 * 33]); o.w = pk2(s[6 * 33], s[7 * 33]);
        *(u32x4*)(WT + (size_t)(n0 + n) * K + k0 + 8 * c) = o; }
    LDS_WAIT();
}
__device__ __forceinline__ void convert_weights(const Params& p, int l, LAS unsigned char* lds, int bid, int G) {
    const int tid = opaque_tid(), wave = tid >> 6, lane = tid & 63;
    LAS float* scr = (LAS float*)(lds + wave * 8448);
    const int gw = bid * 8 + wave, NGW = G * 8;
    constexpr int I1 = 16 * 93, I2 = 16 * 32, I3 = 16 * 128, I4 = 64 * 32;
    for (int it = gw; it < I1 + I2 + I3 + I4; it += NGW) {
        int r = it;
        if (r < I1) { transpose_item(p.in[I_WIN] + (size_t)l * D * NIN, D, NIN, (bf16_t*)(p.ws + WS_WIN), scr, r, lane); continue; } r -= I1;
        if (r < I2) { transpose_item(p.in[I_WOUT] + (size_t)l * D * D, D, D, (bf16_t*)(p.ws + WS_WOUT), scr, r, lane); continue; } r -= I2;
        if (r < I3) { transpose_item(p.in[I_W1] + (size_t)l * D * DFF, D, DFF, (bf16_t*)(p.ws + WS_W1), scr, r, lane); continue; } r -= I3;
        transpose_item(p.in[I_W2] + (size_t)l * DFF * D, DFF, D, (bf16_t*)(p.ws + WS_W2), scr, r, lane);
    }
}

__device__ __forceinline__ void phase_norm(const Params& p, int l, int which, int row_lo, int bid, int G) {
    const int tid = opaque_tid(), wave = tid >> 6, lane = tid & 63;
    const float* MOD = (const float*)(p.ws + WS_MOD) + (size_t)l * 17 * 6144;
    float* Xc = (float*)(p.ws + WS_XC); bf16_t* H = (bf16_t*)(p.ws + WS_H);
    const float* gsrc = (which ? p.in[I_N2G] : p.in[I_N1G]) + l * D;
    const bool first = (l == 0 && which == 0);
    for (int row = row_lo + bid * 8 + wave; row < M; row += G * 8) {
        const float* src = first ? (row < MC ? p.in[I_CTX] + (size_t)row * D : p.in[I_X] + (size_t)(row - MC) * D)
                                 : (row < MC ? Xc + (size_t)row * D : p.out + (size_t)(row - MC) * D);
        f32x4 v[4]; float ss = 0.f;
#pragma unroll
        for (int j = 0; j < 4; ++j) { v[j] = *(const f32x4*)(src + 4 * lane + 256 * j); ss += v[j][0] * v[j][0] + v[j][1] * v[j][1] + v[j][2] * v[j][2] + v[j][3] * v[j][3]; }
        ss = wave_sum(ss); const float rs = rsqrtf(ss * (1.f / D) + 1e-6f);
        if (first) { float* dst = row < MC ? Xc + (size_t)row * D : p.out + (size_t)(row - MC) * D;
#pragma unroll
            for (int j = 0; j < 4; ++j) *(f32x4*)(dst + 4 * lane + 256 * j) = v[j]; }
        const int bi = row < MC ? 16 : ((row - MC) >> 11);
        const float* sh = MOD + (size_t)bi * 6144 + (which ? 3 : 0) * 1024; const float* scl = sh + 1024;
#pragma unroll
        for (int j = 0; j < 4; ++j) { const int col = 4 * lane + 256 * j;
            const f32x4 g = *(const f32x4*)(gsrc + col), s1 = *(const f32x4*)(scl + col), s0 = *(const f32x4*)(sh + col);
            float y[4];
#pragma unroll
            for (int e = 0; e < 4; ++e) y[e] = (v[j][e] * rs * g[e]) * (1.f + s1[e]) + s0[e];
            u32x2 o; o.x = pk2(y[0], y[1]); o.y = pk2(y[2], y[3]); *(u32x2*)(H + (size_t)row * D + col) = o; }
    }
}
__device__ __forceinline__ void phase_final(const Params& p, int bid, int G) {
    const int tid = opaque_tid(), wave = tid >> 6, lane = tid & 63;
    for (int row = bid * 8 + wave; row < ML; row += G * 8) { float* xr = p.out + (size_t)row * D;
        f32x4 v[4]; float ss = 0.f;
#pragma unroll
        for (int j = 0; j < 4; ++j) { v[j] = *(const f32x4*)(xr + 4 * lane + 256 * j); ss += v[j][0] * v[j][0] + v[j][1] * v[j][1] + v[j][2] * v[j][2] + v[j][3] * v[j][3]; }
        ss = wave_sum(ss); const float rs = rsqrtf(ss * (1.f / D) + 1e-6f);
#pragma unroll
        for (int j = 0; j < 4; ++j) { const int col = 4 * lane + 256 * j; const f32x4 g = *(const f32x4*)(p.in[I_FG] + col);
            f32x4 o; o[0] = v[j][0] * rs * g[0]; o[1] = v[j][1] * rs * g[1]; o[2] = v[j][2] * rs * g[2]; o[3] = v[j][3] * rs * g[3]; *(f32x4*)(xr + col) = o; }
    }
}

__device__ __forceinline__ void phase_prep(const Params& p, int l, LAS unsigned char* lds, int bid, int G) {
    const int tid = opaque_tid(), wave = tid >> 6, lane = tid & 63, fr = lane & 15, fq = lane >> 4;
    const bf16_t* P1 = (const bf16_t*)(p.ws + WS_P1);
    bf16_t* RKV = (bf16_t*)(p.ws + WS_RKV); unsigned short* WD = (unsigned short*)(p.ws + WS_WD); bf16_t* AD = (bf16_t*)(p.ws + WS_AD); bf16_t* Gb = (bf16_t*)(p.ws + WS_G);
    LAS bf16_t* At = (LAS bf16_t*)lds;
    LAS bf16_t* Bt = (LAS bf16_t*)(lds + 128 * 136 * 2);
    const float* cw = p.in[I_RCONV] + (size_t)l * 3 * 768;
    for (int tile = bid; tile < M / 128; tile += G) {
        const int row0 = tile * 128;
        for (int i = tid; i < 128 * 96; i += NT) { const int r = i / 96, c = (i % 96) * 8, row = row0 + r;
            const int pos = row < MC ? (row & 255) : ((row - MC) & 2047), len = row < MC ? 256 : 2048;
            const u32x4 z4 = {0u, 0u, 0u, 0u};
            const u32x4 cur = *(const u32x4*)(P1 + (size_t)row * P1W + c);
            const u32x4 prv = pos > 0 ? *(const u32x4*)(P1 + (size_t)(row - 1) * P1W + c) : z4;
            const u32x4 nxt = pos < len - 1 ? *(const u32x4*)(P1 + (size_t)(row + 1) * P1W + c) : z4;
            float a[8], b[8], d[8], o[8]; unpack8(prv, a); unpack8(cur, b); unpack8(nxt, d);
#pragma unroll
            for (int e = 0; e < 8; ++e) o[e] = a[e] * cw[c + e] + b[e] * cw[768 + c + e] + d[e] * cw[1536 + c + e];
            *(u32x4*)(RKV + (size_t)row * 768 + c) = pack8(o); }
        for (int sub = 0; sub < 5; ++sub) {
            const int K = sub < 4 ? 64 : 128, pitch = K + 8;
            const int zoff = 768 + (sub < 2 ? sub * 64 : (sub < 4 ? 128 + (sub - 2) * 64 : 256));
            const float* Bsrc = sub < 2 ? p.in[I_RWUP] + ((size_t)l * 2 + sub) * 64 * 256 : (sub < 4 ? p.in[I_RAUP] + ((size_t)l * 2 + (sub - 2)) * 64 * 256 : p.in[I_RGUP] + (size_t)l * 128 * 256);
            __syncthreads();
            const int k8 = K / 8;
            for (int i = tid; i < 128 * k8; i += NT) { const int r = i / k8, kc = (i % k8) * 8;
                const u32x4 z = *(const u32x4*)(P1 + (size_t)(row0 + r) * P1W + zoff + kc); float f[8]; unpack8(z, f);
                if (sub < 2) {
#pragma unroll
                    for (int e = 0; e < 8; ++e) { const float ex = __expf(2.f * f[e]); f[e] = 1.f - 2.f / (ex + 1.f); }
                } else if (sub == 4) {
#pragma unroll
                    for (int e = 0; e < 8; ++e) f[e] = sigmoidf_(f[e]);
                }
                *(LAS u32x4*)(At + r * pitch + kc) = pack8(f); }
            for (int i = tid; i < K * 256; i += NT) { const int k = i >> 8, n = i & 255; Bt[n * pitch + k] = (bf16_t)f2bf(Bsrc[i]); }
            __syncthreads();
            bf16x8 af[4];
#pragma unroll
            for (int kk = 0; kk < 4; ++kk) if (kk * 32 < K) af[kk] = *(const LAS bf16x8*)(At + (wave * 16 + fr) * pitch + kk * 32 + fq * 8);
            const int row = row0 + wave * 16 + fr;
            for (int nt = 0; nt < 16; ++nt) {
                f32x4 acc = {0.f, 0.f, 0.f, 0.f};
#pragma unroll
                for (int kk = 0; kk < 4; ++kk) if (kk * 32 < K) { const bf16x8 bfr = *(const LAS bf16x8*)(Bt + (nt * 16 + fr) * pitch + kk * 32 + fq * 8);
                    acc = __builtin_amdgcn_mfma_f32_16x16x32_bf16(bfr, af[kk], acc, 0, 0, 0); }
                const int col = nt * 16 + 4 * fq;
                if (sub < 2) { const float* w0 = p.in[I_RW0] + ((size_t)l * 2 + sub) * 256 + col; unsigned h[4];
#pragma unroll
                    for (int j = 0; j < 4; ++j) h[j] = f2h(__expf(-0.606531f * sigmoidf_(w0[j] + acc[j])));
                    u32x2 o; o.x = h[0] | (h[1] << 16); o.y = h[2] | (h[3] << 16); *(u32x2*)(WD + ((size_t)sub * M + row) * 256 + col) = o;
                } else if (sub < 4) { const float* a0 = p.in[I_RA0] + ((size_t)l * 2 + (sub - 2)) * 256 + col;
                    u32x2 o; o.x = pk2(sigmoidf_(a0[0] + acc[0]), sigmoidf_(a0[1] + acc[1])); o.y = pk2(sigmoidf_(a0[2] + acc[2]), sigmoidf_(a0[3] + acc[3]));
                    *(u32x2*)(AD + ((size_t)(sub - 2) * M + row) * 256 + col) = o;
                } else { u32x2 o; o.x = pk2(acc[0], acc[1]); o.y = pk2(acc[2], acc[3]); *(u32x2*)(Gb + (size_t)row * 256 + col) = o; }
            }
        }
        __syncthreads();
    }
}

__device__ __forceinline__ void rwkv_chain(const Params& p, int l, int chain, LAS unsigned char* lds) {
    const int tid = opaque_tid();
    const int b = chain >> 3, h = (chain >> 1) & 3, dir = chain & 1;
    LAS float* Rs = (LAS float*)lds; LAS float* Ws = Rs + 4096; LAS float* KDs = Ws + 4096; LAS float* KKs = KDs + 4096; LAS float* Bs = KKs + 4096; LAS float* Vs = Bs + 4096;
    const bf16_t* RKV = (const bf16_t*)(p.ws + WS_RKV); const unsigned short* WD = (const unsigned short*)(p.ws + WS_WD) + (size_t)dir * M * 256;
    const bf16_t* AD = (const bf16_t*)(p.ws + WS_AD) + (size_t)dir * M * 256;
    float* YR = (float*)(p.ws + WS_H) + (size_t)dir * M * 256;
    const int tk = tid >> 3, c8 = (tid & 7) * 8, ch = h * 64 + c8;
    float kkw[8], kaw[8];
#pragma unroll
    for (int e = 0; e < 8; ++e) { kkw[e] = p.in[I_RKK][l * 256 + ch + e]; kaw[e] = p.in[I_RKA][l * 256 + ch + e]; }
    const int v = tid >> 2, q = tid & 3;
    float S[16];
#pragma unroll
    for (int i = 0; i < 16; ++i) S[i] = 0.f;
    u32x4 rr, rk, rv, ra, rw;
    { const size_t row = (size_t)chain_row(b, dir, tk);
      rr = *(const u32x4*)(RKV + row * 768 + ch); rk = *(const u32x4*)(RKV + row * 768 + 256 + ch); rv = *(const u32x4*)(RKV + row * 768 + 512 + ch);
      ra = *(const u32x4*)(AD + row * 256 + ch); rw = *(const u32x4*)(WD + row * 256 + ch); }
    for (int ci = 0; ci < 36; ++ci) {
        __syncthreads();
        { float r[8], k[8], vv[8], a[8], w[8], kx[8]; unpack8(rr, r); unpack8(rk, k); unpack8(rv, vv); unpack8(ra, a);
          w[0] = h2f(rw.x & 0xffffu); w[1] = h2f(rw.x >> 16); w[2] = h2f(rw.y & 0xffffu); w[3] = h2f(rw.y >> 16); w[4] = h2f(rw.z & 0xffffu); w[5] = h2f(rw.z >> 16); w[6] = h2f(rw.w & 0xffffu); w[7] = h2f(rw.w >> 16);
          float ss = 0.f;
#pragma unroll
          for (int e = 0; e < 8; ++e) { kx[e] = k[e] * kkw[e]; ss += kx[e] * kx[e]; }
          ss += __shfl_xor(ss, 1); ss += __shfl_xor(ss, 2); ss += __shfl_xor(ss, 4);
          const float inv = rsqrtf(ss + 1e-12f);
          float kd[8], kk[8], bb[8];
#pragma unroll
          for (int e = 0; e < 8; ++e) { kk[e] = kx[e] * inv; kd[e] = k[e] * (1.f + (a[e] - 1.f) * kaw[e]); bb[e] = kk[e] * a[e]; }
          const int o = tk * 64 + c8;
          *(LAS f32x4*)(Rs + o) = (f32x4){r[0], r[1], r[2], r[3]}; *(LAS f32x4*)(Rs + o + 4) = (f32x4){r[4], r[5], r[6], r[7]};
          *(LAS f32x4*)(Ws + o) = (f32x4){w[0], w[1], w[2], w[3]}; *(LAS f32x4*)(Ws + o + 4) = (f32x4){w[4], w[5], w[6], w[7]};
          *(LAS f32x4*)(KDs + o) = (f32x4){kd[0], kd[1], kd[2], kd[3]}; *(LAS f32x4*)(KDs + o + 4) = (f32x4){kd[4], kd[5], kd[6], kd[7]};
          *(LAS f32x4*)(KKs + o) = (f32x4){kk[0], kk[1], kk[2], kk[3]}; *(LAS f32x4*)(KKs + o + 4) = (f32x4){kk[4], kk[5], kk[6], kk[7]};
          *(LAS f32x4*)(Bs + o) = (f32x4){bb[0], bb[1], bb[2], bb[3]}; *(LAS f32x4*)(Bs + o + 4) = (f32x4){bb[4], bb[5], bb[6], bb[7]};
          *(LAS f32x4*)(Vs + o) = (f32x4){vv[0], vv[1], vv[2], vv[3]}; *(LAS f32x4*)(Vs + o + 4) = (f32x4){vv[4], vv[5], vv[6], vv[7]}; }
        __syncthreads();
        if (ci + 1 < 36) { const size_t row = (size_t)chain_row(b, dir, (ci + 1) * 64 + tk);
            rr = *(const u32x4*)(RKV + row * 768 + ch); rk = *(const u32x4*)(RKV + row * 768 + 256 + ch); rv = *(const u32x4*)(RKV + row * 768 + 512 + ch);
            ra = *(const u32x4*)(AD + row * 256 + ch); rw = *(const u32x4*)(WD + row * 256 + ch); }
        if (tid < 256) {
            const int row0 = chain_row(b, dir, ci * 64), sgn = dir ? -1 : 1;
            for (int t = 0; t < 64; ++t) {
                const int o = t * 64 + q * 16;
                f32x4 kk4[4], w4[4], b4[4], kd4[4], r4[4];
#pragma unroll
                for (int i = 0; i < 4; ++i) { kk4[i] = *(const LAS f32x4*)(KKs + o + 4 * i); w4[i] = *(const LAS f32x4*)(Ws + o + 4 * i); b4[i] = *(const LAS f32x4*)(Bs + o + 4 * i);
                    kd4[i] = *(const LAS f32x4*)(KDs + o + 4 * i); r4[i] = *(const LAS f32x4*)(Rs + o + 4 * i); }
                const float vv = Vs[t * 64 + v];
                float sa = 0.f;
#pragma unroll
                for (int i = 0; i < 16; ++i) sa += S[i] * kk4[i >> 2][i & 3];
                sa += __shfl_xor(sa, 1); sa += __shfl_xor(sa, 2);
                float y = 0.f;
#pragma unroll
                for (int i = 0; i < 16; ++i) { S[i] = S[i] * w4[i >> 2][i & 3] + (vv * kd4[i >> 2][i & 3] - sa * b4[i >> 2][i & 3]); y += S[i] * r4[i >> 2][i & 3]; }
                y += __shfl_xor(y, 1); y += __shfl_xor(y, 2);
                if (q == 0) YR[(size_t)(row0 + sgn * t) * 256 + h * 64 + v] = y;
            }
        }
    }
    __syncthreads();
}

__device__ __forceinline__ float log_sigmoid_(float x) { return fminf(x, 0.f) - log1pf(__expf(-fabsf(x))); }
__device__ __forceinline__ void mlstm_chain(const Params& p, int l, int chain, LAS unsigned char* lds) {
    const int tid = opaque_tid(), wave = tid >> 6, lane = tid & 63, fr = lane & 15, fq = lane >> 4;
    const int b = chain >> 3, h = (chain >> 1) & 3, dir = chain & 1;
    constexpr int PT = 72;
    LAS bf16_t* Qs = (LAS bf16_t*)lds; LAS bf16_t* Ks = Qs + 64 * PT; LAS bf16_t* Kt = Ks + 64 * PT; LAS bf16_t* Vt = Kt + 64 * PT; LAS bf16_t* Ss = Vt + 64 * PT; LAS bf16_t* Cs = Ss + 64 * PT;
    LAS float* fb = (LAS float*)(lds + 6 * 64 * PT * 2);
    LAS float* ib = fb; LAS float* mxs = fb + 64; LAS float* wint = fb + 128; LAS float* emt = fb + 192; LAS float* gw = fb + 256; LAS float* nvec = fb + 320; LAS float* nq = fb + 384;
    LAS float* dsum = fb + 448;   LAS float* scal = fb + 576;
    const bf16_t* P2 = (const bf16_t*)(p.ws + WS_P2);
    bf16_t* YM = (bf16_t*)(p.ws + WS_YM) + (size_t)dir * M * 256;
    const float* cw = p.in[I_MCONV] + (size_t)l * 3 * 512;
    const float bi_ = p.in[I_MBI][l * 8 + dir * 4 + h], bf_ = p.in[I_MBF][l * 8 + dir * 4 + h];
    for (int i = tid; i < 64 * PT; i += NT) Cs[i] = 0;
    if (tid < 64) nvec[tid] = 0.f;
    if (tid == 0) { scal[0] = 0.f; scal[1] = 0.f; }
    f32x4 accC[2] = {{0.f, 0.f, 0.f, 0.f}, {0.f, 0.f, 0.f, 0.f}};
    const int tA = wave >> 1, tB0 = 2 * (wave & 1);
    for (int ci = 0; ci < 36; ++ci) {
        __syncthreads();
        { const int t = tid >> 3, c8 = (tid & 7) * 8; const int row = chain_row(b, dir, ci * 64 + t);
          const int pos = row < MC ? (row & 255) : ((row - MC) & 2047), len = row < MC ? 256 : 2048;
          const u32x4 z4 = {0u, 0u, 0u, 0u};
          const bf16_t* base = P2 + (size_t)row * P2W;
#pragma unroll
          for (int part = 0; part < 2; ++part) { const int col = 768 + part * 256 + h * 64 + c8; const int wc = part * 256 + h * 64 + c8;
              const u32x4 cur = *(const u32x4*)(base + col);
              const u32x4 prv = pos > 0 ? *(const u32x4*)(base - P2W + col) : z4;
              const u32x4 nxt = pos < len - 1 ? *(const u32x4*)(base + P2W + col) : z4;
              float a[8], bb[8], d[8], o[8]; unpack8(prv, a); unpack8(cur, bb); unpack8(nxt, d);
#pragma unroll
              for (int e = 0; e < 8; ++e) { const float x = a[e] * cw[wc + e] + bb[e] * cw[512 + wc + e] + d[e] * cw[1024 + wc + e]; const float s = x * sigmoidf_(x); o[e] = part ? s * 0.125f : s; }
              const u32x4 pk = pack8(o);
              if (part == 0) *(LAS u32x4*)(Qs + t * PT + c8) = pk;
              else { *(LAS u32x4*)(Ks + t * PT + c8) = pk;
#pragma unroll
                  for (int e = 0; e < 8; ++e) Kt[(c8 + e) * PT + t] = (bf16_t)f2bf(o[e]); } }
          const u32x4 vr = *(const u32x4*)(base + 1280 + h * 64 + c8);
          Vt[(c8 + 0) * PT + t] = (bf16_t)(vr.x & 0xffffu); Vt[(c8 + 1) * PT + t] = (bf16_t)(vr.x >> 16); Vt[(c8 + 2) * PT + t] = (bf16_t)(vr.y & 0xffffu); Vt[(c8 + 3) * PT + t] = (bf16_t)(vr.y >> 16);
          Vt[(c8 + 4) * PT + t] = (bf16_t)(vr.z & 0xffffu); Vt[(c8 + 5) * PT + t] = (bf16_t)(vr.z >> 16); Vt[(c8 + 6) * PT + t] = (bf16_t)(vr.w & 0xffffu); Vt[(c8 + 7) * PT + t] = (bf16_t)(vr.w >> 16); }
        if (wave == 0) { const int row = chain_row(b, dir, ci * 64 + lane); const bf16_t* gp = P2 + (size_t)row * P2W + 1792;
            const float ig = bf2f(gp[dir * 4 + h]) + bi_, fg = log_sigmoid_(bf2f(gp[8 + dir * 4 + h]) + bf_);
            float bc = fg;
#pragma unroll
            for (int o = 1; o < 64; o <<= 1) { const float u = __shfl_up(bc, o); if (lane >= o) bc += u; }
            const float ibv = ig - bc; float pm = ibv;
#pragma unroll
            for (int o = 1; o < 64; o <<= 1) { const float u = __shfl_up(pm, o); if (lane >= o) pm = fmaxf(pm, u); }
            const float m = scal[0]; const float mx = fmaxf(m, pm); const float mx63 = __shfl(mx, 63), b63 = __shfl(bc, 63);
            ib[lane] = ibv; mxs[lane] = mx; wint[lane] = __expf(m - mx); emt[lane] = __expf(-(bc + mx)); gw[lane] = __expf(ibv - mx63);
            LDS_WAIT();
            if (lane == 0) { scal[1] = __expf(m - mx63); scal[0] = b63 + mx63; } }
        __syncthreads();
        {
#pragma unroll
            for (int ct = 0; ct < 2; ++ct) { const int st = tB0 + ct; f32x4 acc = {0.f, 0.f, 0.f, 0.f};
#pragma unroll
                for (int kk = 0; kk < 2; ++kk) { const bf16x8 a = *(const LAS bf16x8*)(Qs + (tA * 16 + fr) * PT + kk * 32 + fq * 8); const bf16x8 bq = *(const LAS bf16x8*)(Ks + (st * 16 + fr) * PT + kk * 32 + fq * 8);
                    acc = __builtin_amdgcn_mfma_f32_16x16x32_bf16(a, bq, acc, 0, 0, 0); }
                const int s = st * 16 + fr; const float ibs = ib[s];
                float rs[4];
#pragma unroll
                for (int j = 0; j < 4; ++j) { const int t = tA * 16 + fq * 4 + j; const float wv = s <= t ? __expf(ibs - mxs[t]) : 0.f; const float sv = acc[j] * wv; rs[j] = sv; Ss[t * PT + s] = (bf16_t)f2bf(sv); }
#pragma unroll
                for (int j = 0; j < 4; ++j) { float r = rs[j]; r += __shfl_xor(r, 1); r += __shfl_xor(r, 2); r += __shfl_xor(r, 4); r += __shfl_xor(r, 8); rs[j] = r; }
                if (fr == 0) {
#pragma unroll
                    for (int j = 0; j < 4; ++j) { const int t = tA * 16 + fq * 4 + j; if (ct == 0) dsum[(wave & 1) * 64 + t] = rs[j]; else dsum[(wave & 1) * 64 + t] += rs[j]; } }
                LDS_WAIT();
            }
            { const int t = tid >> 3, k8 = (tid & 7) * 8; float f[8]; unpack8(*(const LAS u32x4*)(Qs + t * PT + k8), f); float s = 0.f;
#pragma unroll
              for (int e = 0; e < 8; ++e) s += f[e] * nvec[k8 + e];
              s += __shfl_xor(s, 1); s += __shfl_xor(s, 2); s += __shfl_xor(s, 4);
              if ((tid & 7) == 0) nq[t] = s; }
        }
        __syncthreads();
        {
            const int row0 = chain_row(b, dir, ci * 64), sgn = dir ? -1 : 1;
#pragma unroll
            for (int ct = 0; ct < 2; ++ct) { const int vt = tB0 + ct; f32x4 a1 = {0.f, 0.f, 0.f, 0.f}, a2 = {0.f, 0.f, 0.f, 0.f};
#pragma unroll
                for (int kk = 0; kk < 2; ++kk) { const bf16x8 sa = *(const LAS bf16x8*)(Ss + (tA * 16 + fr) * PT + kk * 32 + fq * 8); const bf16x8 vb = *(const LAS bf16x8*)(Vt + (vt * 16 + fr) * PT + kk * 32 + fq * 8);
                    a1 = __builtin_amdgcn_mfma_f32_16x16x32_bf16(sa, vb, a1, 0, 0, 0);
                    const bf16x8 qa = *(const LAS bf16x8*)(Qs + (tA * 16 + fr) * PT + kk * 32 + fq * 8); const bf16x8 cb = *(const LAS bf16x8*)(Cs + (vt * 16 + fr) * PT + kk * 32 + fq * 8);
                    a2 = __builtin_amdgcn_mfma_f32_16x16x32_bf16(qa, cb, a2, 0, 0, 0); }
#pragma unroll
                for (int j = 0; j < 4; ++j) { const int t = tA * 16 + fq * 4 + j; const float wi = wint[t];
                    const float den = dsum[t] + dsum[64 + t] + wi * nq[t]; const float hv = (a1[j] + wi * a2[j]) / fmaxf(fabsf(den), emt[t]);
                    YM[(size_t)(row0 + sgn * t) * 256 + h * 64 + vt * 16 + fr] = (bf16_t)f2bf(hv); } }
        }
        {
            const float dec = scal[1];
#pragma unroll
            for (int ct = 0; ct < 2; ++ct) { const int kt = tB0 + ct; f32x4 acc = accC[ct] * dec;
#pragma unroll
                for (int kk = 0; kk < 2; ++kk) { float f[8]; unpack8(*(const LAS u32x4*)(Vt + (tA * 16 + fr) * PT + kk * 32 + fq * 8), f);
                    const f32x4 g0 = *(const LAS f32x4*)(gw + kk * 32 + fq * 8), g1 = *(const LAS f32x4*)(gw + kk * 32 + fq * 8 + 4);
                    f[0] *= g0[0]; f[1] *= g0[1]; f[2] *= g0[2]; f[3] *= g0[3]; f[4] *= g1[0]; f[5] *= g1[1]; f[6] *= g1[2]; f[7] *= g1[3];
                    const u32x4 pa = pack8(f); const bf16x8 a = __builtin_bit_cast(bf16x8, pa);
                    const bf16x8 kb = *(const LAS bf16x8*)(Kt + (kt * 16 + fr) * PT + kk * 32 + fq * 8);
                    acc = __builtin_amdgcn_mfma_f32_16x16x32_bf16(a, kb, acc, 0, 0, 0); }
                accC[ct] = acc; }
        }
        __syncthreads();
        {
            const float dec = scal[1];
            if (tid < 64) { float s = 0.f;
                for (int sI = 0; sI < 64; ++sI) s += gw[sI] * bf2f(Ks[sI * PT + tid]);
                nvec[tid] = dec * nvec[tid] + s; }
#pragma unroll
            for (int ct = 0; ct < 2; ++ct) { const int kt = tB0 + ct;
#pragma unroll
                for (int j = 0; j < 4; ++j) Cs[(tA * 16 + fq * 4 + j) * PT + kt * 16 + fr] = (bf16_t)f2bf(accC[ct][j]); }
        }
    }
    __syncthreads();
}

__device__ __forceinline__ void attn_unit(const Params& p, int l, int u, LAS unsigned char* lds) {
    const int tid = opaque_tid(), wave = tid >> 6, lane = tid & 63, fr = lane & 15, fq = lane >> 4;
    constexpr int PT = 72;
    LAS bf16_t* Ks = (LAS bf16_t*)lds; LAS bf16_t* Vt = Ks + 64 * PT;
    const bf16_t* P2 = (const bf16_t*)(p.ws + WS_P2); bf16_t* Y = (bf16_t*)(p.ws + WS_P1);
    const float* ROPE = (const float*)(p.ws + WS_ROPE);
    int b, kvh, gp, qb, qrow0; bool lat;
    if (u < 1024) { lat = true; gp = u & 1; qb = (u >> 1) & 15; kvh = (u >> 5) & 1; b = u >> 6; qrow0 = MC + b * SEQ + qb * 128; }
    else { const int w = u - 1024; lat = false; gp = w & 1; qb = (w >> 1) & 1; kvh = (w >> 2) & 1; b = w >> 3; qrow0 = b * TC + qb * 128; }
    const int g = gp * 2 + (wave >> 2), head = kvh * 4 + g, qi0 = (wave & 3) * 32;
    bf16x8 Qf[2][2];
#pragma unroll
    for (int mt = 0; mt < 2; ++mt) { const int qi = qi0 + mt * 16 + fr; const bf16_t* qp = P2 + (size_t)(qrow0 + qi) * P2W + head * 64 + fq * 8;
        float a[8], c[8]; unpack8(*(const u32x4*)qp, a); unpack8(*(const u32x4*)(qp + 32), c);
        if (lat) { const float* rp = ROPE + ((size_t)(qb * 128 + qi) * 32 + fq * 8) * 2;
#pragma unroll
            for (int e = 0; e < 8; ++e) { const float cs = rp[2 * e], sn = rp[2 * e + 1]; const float u1 = a[e], u2 = c[e]; a[e] = u1 * cs - u2 * sn; c[e] = u1 * sn + u2 * cs; } }
#pragma unroll
        for (int e = 0; e < 8; ++e) { a[e] *= 0.125f; c[e] *= 0.125f; }
        const u32x4 pa = pack8(a), pc = pack8(c); Qf[mt][0] = __builtin_bit_cast(bf16x8, pa); Qf[mt][1] = __builtin_bit_cast(bf16x8, pc); }
    const float sink = p.in[I_SINK][l * 8 + head];
    float mrun[2] = {sink, sink}, lrun[2] = {fq == 0 ? 1.f : 0.f, fq == 0 ? 1.f : 0.f};
    f32x4 O[2][4];
#pragma unroll
    for (int mt = 0; mt < 2; ++mt)
#pragma unroll
        for (int dt = 0; dt < 4; ++dt) O[mt][dt] = (f32x4){0.f, 0.f, 0.f, 0.f};
    const int ntiles = lat ? 10 : 4;
    for (int ti = 0; ti < ntiles; ++ti) {
        const bool band = ti >= 4; const int kpos0 = band ? qb * 128 - 128 + (ti - 4) * 64 : 0;
        if (band && (kpos0 < 0 || kpos0 >= SEQ)) continue;
        const int krow0 = band ? MC + b * SEQ + kpos0 : b * TC + ti * 64;
        __syncthreads();
        if (tid < 256) { const int key = tid >> 2, gr = tid & 3; const bf16_t* kp = P2 + (size_t)(krow0 + key) * P2W + 512 + kvh * 64 + gr * 8;
            u32x4 lo = *(const u32x4*)kp, hi = *(const u32x4*)(kp + 32);
            if (band) { float a[8], c[8]; unpack8(lo, a); unpack8(hi, c); const float* rp = ROPE + ((size_t)(kpos0 + key) * 32 + gr * 8) * 2;
#pragma unroll
                for (int e = 0; e < 8; ++e) { const float cs = rp[2 * e], sn = rp[2 * e + 1]; const float u1 = a[e], u2 = c[e]; a[e] = u1 * cs - u2 * sn; c[e] = u1 * sn + u2 * cs; }
                lo = pack8(a); hi = pack8(c); }
            *(LAS u32x4*)(Ks + key * PT + gr * 8) = lo; *(LAS u32x4*)(Ks + key * PT + 32 + gr * 8) = hi;
        } else { const int w = tid - 256, key = w >> 2, gr = w & 3; const bf16_t* vp = P2 + (size_t)(krow0 + key) * P2W + 640 + kvh * 64 + gr * 16;
            const u32x4 v0 = *(const u32x4*)vp, v1 = *(const u32x4*)(vp + 8); const int d0 = gr * 16;
            Vt[(d0 + 0) * PT + key] = (bf16_t)(v0.x & 0xffffu); Vt[(d0 + 1) * PT + key] = (bf16_t)(v0.x >> 16); Vt[(d0 + 2) * PT + key] = (bf16_t)(v0.y & 0xffffu); Vt[(d0 + 3) * PT + key] = (bf16_t)(v0.y >> 16);
            Vt[(d0 + 4) * PT + key] = (bf16_t)(v0.z & 0xffffu); Vt[(d0 + 5) * PT + key] = (bf16_t)(v0.z >> 16); Vt[(d0 + 6) * PT + key] = (bf16_t)(v0.w & 0xffffu); Vt[(d0 + 7) * PT + key] = (bf16_t)(v0.w >> 16);
            Vt[(d0 + 8) * PT + key] = (bf16_t)(v1.x & 0xffffu); Vt[(d0 + 9) * PT + key] = (bf16_t)(v1.x >> 16); Vt[(d0 + 10) * PT + key] = (bf16_t)(v1.y & 0xffffu); Vt[(d0 + 11) * PT + key] = (bf16_t)(v1.y >> 16);
            Vt[(d0 + 12) * PT + key] = (bf16_t)(v1.z & 0xffffu); Vt[(d0 + 13) * PT + key] = (bf16_t)(v1.z >> 16); Vt[(d0 + 14) * PT + key] = (bf16_t)(v1.w & 0xffffu); Vt[(d0 + 15) * PT + key] = (bf16_t)(v1.w >> 16); }
        __syncthreads();
        f32x4 Sx[2][4];
#pragma unroll
        for (int nt = 0; nt < 4; ++nt) { const bf16x8 k0 = *(const LAS bf16x8*)(Ks + (nt * 16 + fr) * PT + fq * 8), k1 = *(const LAS bf16x8*)(Ks + (nt * 16 + fr) * PT + 32 + fq * 8);
#pragma unroll
            for (int mt = 0; mt < 2; ++mt) { f32x4 acc = {0.f, 0.f, 0.f, 0.f};
                acc = __builtin_amdgcn_mfma_f32_16x16x32_bf16(k0, Qf[mt][0], acc, 0, 0, 0); acc = __builtin_amdgcn_mfma_f32_16x16x32_bf16(k1, Qf[mt][1], acc, 0, 0, 0); Sx[mt][nt] = acc; } }
        bf16x8 Pf[2][2];
#pragma unroll
        for (int mt = 0; mt < 2; ++mt) {
            if (band) { const int qp = qb * 128 + qi0 + mt * 16 + fr;
#pragma unroll
                for (int nt = 0; nt < 4; ++nt)
#pragma unroll
                    for (int j = 0; j < 4; ++j) { const int dlt = kpos0 + nt * 16 + 4 * fq + j - qp; if (dlt > 128 || dlt < -128) Sx[mt][nt][j] = -1e30f; } }
            float mx = mrun[mt];
#pragma unroll
            for (int nt = 0; nt < 4; ++nt)
#pragma unroll
                for (int j = 0; j < 4; ++j) mx = fmaxf(mx, Sx[mt][nt][j]);
            mx = fmaxf(mx, __shfl_xor(mx, 16)); mx = fmaxf(mx, __shfl_xor(mx, 32));
            const float alpha = __expf(mrun[mt] - mx); mrun[mt] = mx; float ls = 0.f;
#pragma unroll
            for (int nt = 0; nt < 4; ++nt)
#pragma unroll
                for (int j = 0; j < 4; ++j) { const float e = __expf(Sx[mt][nt][j] - mx); Sx[mt][nt][j] = e; ls += e; }
            lrun[mt] = lrun[mt] * alpha + ls;
#pragma unroll
            for (int dt = 0; dt < 4; ++dt) O[mt][dt] = O[mt][dt] * alpha;
#pragma unroll
            for (int kk = 0; kk < 2; ++kk) { u32x4 pw; pw.x = pk2(Sx[mt][2 * kk][0], Sx[mt][2 * kk][1]); pw.y = pk2(Sx[mt][2 * kk][2], Sx[mt][2 * kk][3]);
                pw.z = pk2(Sx[mt][2 * kk + 1][0], Sx[mt][2 * kk + 1][1]); pw.w = pk2(Sx[mt][2 * kk + 1][2], Sx[mt][2 * kk + 1][3]); Pf[mt][kk] = __builtin_bit_cast(bf16x8, pw); }
        }
#pragma unroll
        for (int dt = 0; dt < 4; ++dt)
#pragma unroll
            for (int kk = 0; kk < 2; ++kk) { const u32x2 va = *(const LAS u32x2*)(Vt + (dt * 16 + fr) * PT + kk * 32 + 4 * fq), vb = *(const LAS u32x2*)(Vt + (dt * 16 + fr) * PT + kk * 32 + 16 + 4 * fq);
                const u32x4 vw = {va.x, va.y, vb.x, vb.y}; const bf16x8 vf = __builtin_bit_cast(bf16x8, vw);
#pragma unroll
                for (int mt = 0; mt < 2; ++mt) O[mt][dt] = __builtin_amdgcn_mfma_f32_16x16x32_bf16(vf, Pf[mt][kk], O[mt][dt], 0, 0, 0); }
    }
#pragma unroll
    for (int mt = 0; mt < 2; ++mt) { float ls = lrun[mt]; ls += __shfl_xor(ls, 16); ls += __shfl_xor(ls, 32); const float il = 1.f / ls;
        bf16_t* yp = Y + (size_t)(qrow0 + qi0 + mt * 16 + fr) * D + 256 + head * 64 + 4 * fq;
#pragma unroll
        for (int dt = 0; dt < 4; ++dt) { const f32x4 o = O[mt][dt] * il; u32x2 w; w.x = pk2(o[0], o[1]); w.y = pk2(o[2], o[3]); *(u32x2*)(yp + dt * 16) = w; } }
    __syncthreads();
}

__device__ __forceinline__ void phase_post(const Params& p, int l, int row_lo, int bid, int G) {
    const int tid = opaque_tid(), wave = tid >> 6, lane = tid & 63, c = 4 * lane;
    const float* YR = (const float*)(p.ws + WS_H); const bf16_t* YM = (const bf16_t*)(p.ws + WS_YM); const bf16_t* RKV = (const bf16_t*)(p.ws + WS_RKV);
    const bf16_t* Gb = (const bf16_t*)(p.ws + WS_G); const bf16_t* P2 = (const bf16_t*)(p.ws + WS_P2); bf16_t* Y = (bf16_t*)(p.ws + WS_P1);
    const f32x4 lnw = *(const f32x4*)(p.in[I_RLNW] + l * 256 + c), lnb = *(const f32x4*)(p.in[I_RLNB] + l * 256 + c), rk_ = *(const f32x4*)(p.in[I_RRK] + l * 256 + c),
                ng = *(const f32x4*)(p.in[I_MNG] + l * 256 + c);
    for (int row = row_lo + bid * 8 + wave; row < M; row += G * 8) {
        { const f32x4 y0 = *(const f32x4*)(YR + (size_t)row * 256 + c), y1 = *(const f32x4*)(YR + ((size_t)M + row) * 256 + c); f32x4 y = y0 + y1;
          float s = y[0] + y[1] + y[2] + y[3]; s += __shfl_xor(s, 1); s += __shfl_xor(s, 2); s += __shfl_xor(s, 4); s += __shfl_xor(s, 8); const float mu = s * (1.f / 64.f);
          y = y - mu; float q = y[0] * y[0] + y[1] * y[1] + y[2] * y[2] + y[3] * y[3]; q += __shfl_xor(q, 1); q += __shfl_xor(q, 2); q += __shfl_xor(q, 4); q += __shfl_xor(q, 8);
          const float rs = rsqrtf(q * (1.f / 64.f) + 64e-5f);
          const u32x2 rw = *(const u32x2*)(RKV + (size_t)row * 768 + c), kw = *(const u32x2*)(RKV + (size_t)row * 768 + 256 + c), vw = *(const u32x2*)(RKV + (size_t)row * 768 + 512 + c),
                      gw_ = *(const u32x2*)(Gb + (size_t)row * 256 + c);
          const float r[4] = {bflo(rw.x), bfhi(rw.x), bflo(rw.y), bfhi(rw.y)}, k[4] = {bflo(kw.x), bfhi(kw.x), bflo(kw.y), bfhi(kw.y)}, v[4] = {bflo(vw.x), bfhi(vw.x), bflo(vw.y), bfhi(vw.y)},
                      g[4] = {bflo(gw_.x), bfhi(gw_.x), bflo(gw_.y), bfhi(gw_.y)};
          float bs = r[0] * k[0] * rk_[0] + r[1] * k[1] * rk_[1] + r[2] * k[2] * rk_[2] + r[3] * k[3] * rk_[3];
          bs += __shfl_xor(bs, 1); bs += __shfl_xor(bs, 2); bs += __shfl_xor(bs, 4); bs += __shfl_xor(bs, 8);
          float o[4];
#pragma unroll
          for (int e = 0; e < 4; ++e) o[e] = (y[e] * rs * lnw[e] + lnb[e] + bs * v[e]) * g[e];
          u32x2 w; w.x = pk2(o[0], o[1]); w.y = pk2(o[2], o[3]); *(u32x2*)(Y + (size_t)row * D + c) = w; }
        { const u32x2 h0 = *(const u32x2*)(YM + (size_t)row * 256 + c), h1 = *(const u32x2*)(YM + ((size_t)M + row) * 256 + c);
          f32x4 y = {bflo(h0.x) + bflo(h1.x), bfhi(h0.x) + bfhi(h1.x), bflo(h0.y) + bflo(h1.y), bfhi(h0.y) + bfhi(h1.y)};
          float s = y[0] + y[1] + y[2] + y[3]; s += __shfl_xor(s, 1); s += __shfl_xor(s, 2); s += __shfl_xor(s, 4); s += __shfl_xor(s, 8); const float mu = s * (1.f / 64.f);
          y = y - mu; float q = y[0] * y[0] + y[1] * y[1] + y[2] * y[2] + y[3] * y[3]; q += __shfl_xor(q, 1); q += __shfl_xor(q, 2); q += __shfl_xor(q, 4); q += __shfl_xor(q, 8);
          const float rs = rsqrtf(q * (1.f / 64.f) + 1e-6f);
          const u32x2 ow = *(const u32x2*)(P2 + (size_t)row * P2W + 1536 + c); const float og[4] = {bflo(ow.x), bfhi(ow.x), bflo(ow.y), bfhi(ow.y)};
          float o[4];
#pragma unroll
          for (int e = 0; e < 4; ++e) o[e] = sigmoidf_(og[e]) * (y[e] * rs * ng[e]);
          u32x2 w; w.x = pk2(o[0], o[1]); w.y = pk2(o[2], o[3]); *(u32x2*)(Y + (size_t)row * D + 768 + c) = w; }
    }
}

constexpr int N_PHASES = 2 + 9 * DEPTH;
__global__ void __launch_bounds__(NT, 2) fwd_megakernel(Params p) {
    extern __shared__ __attribute__((aligned(16))) unsigned char lds_raw[];
    LAS unsigned char* lds = (LAS unsigned char*)lds_raw;
    cg::grid_group grid = cg::this_grid();
    for (int ph = p.ph_lo; ph < p.ph_hi; ++ph) {
        int bid = blockIdx.x, G = gridDim.x; asm volatile("" : "+s"(bid), "+s"(G));
        float* Xc = (float*)(p.ws + WS_XC);
#ifndef PHM
#define PHM 0xffff
#endif
        if (ph == 0) { if (PHM & 1) phase_adaln(p, lds, bid, G); }
        else if (ph == N_PHASES - 1) { if (PHM & 2) phase_final(p, bid, G); }
        else {
            const int l = (ph - 1) / 9, s = (ph - 1) % 9; const bool last = (l == DEPTH - 1);
            const int row_lo = last ? MC : 0;
            const float* modl = (const float*)(p.ws + WS_MOD) + (size_t)l * 17 * 6144;
            if (s == 0) { if (PHM & 4) convert_weights(p, l, lds, bid, G); if (PHM & 8) phase_norm(p, l, 0, 0, bid, G); }
            else if (s == 1) { if (PHM & 16) { pg8::Gemm g{(const pg8::bf16_t*)(p.ws + WS_H), (const pg8::bf16_t*)(p.ws + WS_WIN), M, NINP, D}; pg8::StaticOrder S; S.init(M, NINP, G, bid);
                EpiIn E{(bf16_t*)(p.ws + WS_P1), (bf16_t*)(p.ws + WS_P2)}; pg8::gemm_phase<EpiIn, pg8::StaticOrder, false>(lds, g, S, E, nullptr); } }
            else if (s == 2) { if (PHM & 32) phase_prep(p, l, lds, bid, G); }
            else if (s == 3) {
                const int natt = last ? 1024 : 1152, total = 256 + natt;
                int it = (G >= 256 && bid >= 256) ? total : bid;
                while (it < total) {
                    if (it < 128) { if (PHM & 64) rwkv_chain(p, l, it, lds); }
                    else if (it < 256) { if (PHM & 128) mlstm_chain(p, l, it - 128, lds); }
                    else { if (PHM & 256) attn_unit(p, l, it - 256, lds); }
                    if (G >= 256) { if (bid < 128) break; it = (it < 256) ? 256 + (bid - 128) : it + 128; }
                    else it += G;
                }
            }
            else if (s == 4) { if (PHM & 1024) phase_post(p, l, row_lo, bid, G); }
            else if (s == 5) { if (PHM & 2048) { const int Mg = M - row_lo; pg8::Gemm g{(const pg8::bf16_t*)(p.ws + WS_P1) + (size_t)row_lo * D, (const pg8::bf16_t*)(p.ws + WS_WOUT), Mg, D, D}; pg8::StaticOrder S; S.init(Mg, D, G, bid);
                EpiRes E{Xc, p.out, modl, 2, row_lo}; pg8::gemm_phase<EpiRes, pg8::StaticOrder, false>(lds, g, S, E, nullptr); } }
            else if (s == 6) { if (PHM & 4096) phase_norm(p, l, 1, row_lo, bid, G); }
            else if (s == 7) { if (PHM & 8192) { const int Mg = M - row_lo; pg8::Gemm g{(const pg8::bf16_t*)(p.ws + WS_H) + (size_t)row_lo * D, (const pg8::bf16_t*)(p.ws + WS_W1), Mg, DFF, D}; pg8::StaticOrder S; S.init(Mg, DFF, G, bid);
                EpiSq E{(bf16_t*)(p.ws + WS_P1) + (size_t)row_lo * DFF}; pg8::gemm_phase<EpiSq, pg8::StaticOrder, false>(lds, g, S, E, nullptr); } }
            else if (PHM & 16384) { const int Mg = M - row_lo; pg8::Gemm g{(const pg8::bf16_t*)(p.ws + WS_P1) + (size_t)row_lo * DFF, (const pg8::bf16_t*)(p.ws + WS_W2), Mg, D, DFF}; pg8::StaticOrder S; S.init(Mg, D, G, bid);
                EpiRes E{Xc, p.out, modl, 5, row_lo}; pg8::gemm_phase<EpiRes, pg8::StaticOrder, false>(lds, g, S, E, nullptr); }
        }
        if (ph + 1 < p.ph_hi) grid.sync();
    }
}

#ifndef MK_ONE_LAUNCH
#define MK_ONE_LAUNCH 1
#endif
extern "C" void kernel_launch(void* const* d_in, const int* in_sizes, int n_in, void* d_out, int out_size, void* d_ws, size_t ws_size, hipStream_t stream) {
    static int grid = 0;
    if (grid == 0) {
        if (n_in != 29 || out_size != ML * D || ws_size < WS_END) { fprintf(stderr, "kernel_launch: unexpected shapes: n_in %d out %d ws %zu (need %zu)\n", n_in, out_size, ws_size, (size_t)WS_END); grid = -1; return; }
        int dev = 0, cus = 0, per_cu = 0;
        hipGetDevice(&dev); hipDeviceGetAttribute(&cus, hipDeviceAttributeMultiprocessorCount, dev);
        if (hipFuncSetAttribute((const void*)fwd_megakernel, hipFuncAttributeMaxDynamicSharedMemorySize, LDS_BYTES) != hipSuccess) { fprintf(stderr, "kernel_launch: hipFuncSetAttribute failed\n"); grid = -1; return; }
        if (hipOccupancyMaxActiveBlocksPerMultiprocessor(&per_cu, (const void*)fwd_megakernel, NT, LDS_BYTES) != hipSuccess || per_cu < 1) { fprintf(stderr, "kernel_launch: occupancy query says %d\n", per_cu); per_cu = 1; }
        (void)hipGetLastError();
        grid = cus * per_cu;
        fprintf(stderr, "kernel_launch: grid %d (cus %d x %d)\n", grid, cus, per_cu);
    }
    if (grid < 0) return;
    Params p{};
    for (int i = 0; i < 29; ++i) p.in[i] = (const float*)d_in[i];
    p.out = (float*)d_out; p.ws = (unsigned char*)d_ws;
#if MK_ONE_LAUNCH
    p.ph_lo = 0; p.ph_hi = N_PHASES;
    { void* args[] = {&p}; hipError_t e = hipLaunchCooperativeKernel((const void*)fwd_megakernel, dim3(grid), dim3(NT), args, LDS_BYTES, stream);
      if (e != hipSuccess) fprintf(stderr, "cooperative launch failed: %s (grid %d)\n", hipGetErrorString(e), grid); }
#else
    for (int ph = 0; ph < N_PHASES; ++ph) { p.ph_lo = ph; p.ph_hi = ph + 1; hipLaunchKernelGGL(fwd_megakernel, dim3(grid), dim3(NT), LDS_BYTES, stream, p); }
#endif
}
```

```cpp
#include <hip/hip_runtime.h>
#include <hip/hip_cooperative_groups.h>
#include <cstdio>
#include <cstdint>
namespace cg = cooperative_groups;

__device__ __forceinline__ int opaque_tid() { int t = threadIdx.x; asm volatile("" : "+v"(t)); return t; }
namespace pg8 {
#define PG8_LAS __attribute__((address_space(3)))
typedef unsigned short bf16_t;
typedef short bf16x8 __attribute__((ext_vector_type(8)));
typedef float f32x4 __attribute__((ext_vector_type(4)));
typedef unsigned u32x4 __attribute__((ext_vector_type(4)));
constexpr int BM = 256, BK = 64, HALF = 128, HTB = HALF * BK * 2  , STAGE_BYTES = 8 * HTB, NXCD = 8, WGM = 8;

__host__ __device__ __forceinline__ int lds_byte(int r, int c) { const int st = (r >> 4) * 2 + (c >> 5), rr = r & 15, cc = c & 31, ob = rr * 64 + cc * 2; return st * 1024 + (ob ^ (((ob >> 9) & 1) << 5)); }
__host__ __device__ __forceinline__ void stage_rc(int b, int& R, int& C) { const int st = b / 1024, sb = b % 1024, swz = sb ^ (((sb >> 9) & 1) << 5); R = (st >> 1) * 16 + swz / 64; C = (st & 1) * 32 + (swz % 64) / 2; }
__host__ __device__ __forceinline__ int perm32(int rho) { const int n = rho >> 4, i = rho & 15; return 8 * (i >> 2) + 4 * n + (i & 3); }

struct Unit { int pm, pn; };
struct Gemm { const bf16_t* A; const bf16_t* Bt; int M, N, K; };

struct StaticOrder {
    int nM, nN, nwg, G, c;
    __host__ __device__ void init(int M, int N, int G_, int c_) { nM = M / BM; nN = N / BM; nwg = nM * nN; G = G_; c = c_; }
    __host__ __device__ bool next(int i, Unit& u) const {
        const long L = (long)i * G + c; if (L >= nwg) return false;
        int wgid = (int)L; { const int q = nwg / NXCD, r = nwg % NXCD, xcd = wgid % NXCD, off = wgid / NXCD; wgid = (xcd < r ? xcd * (q + 1) : r * (q + 1) + (xcd - r) * q) + off; }
        const int nig = WGM * nN, gid = wgid / nig, fm = gid * WGM, gsz = (nM - fm) < WGM ? (nM - fm) : WGM;
        u.pm = fm + ((wgid % nig) % gsz); u.pn = (wgid % nig) / gsz; return true;
    }
    __device__ __forceinline__ void a_ready(const Unit&) const {}
    __device__ __forceinline__ void done(const Unit&) const {}
};

template <class Epi, class Sched, bool ALIGN_EPI = false, bool SP2 = false>
__device__ __forceinline__ void gemm_phase(PG8_LAS unsigned char* lds, const Gemm g, const Sched& S, const Epi& E) {
    const int tid = opaque_tid(), wid = __builtin_amdgcn_readfirstlane(tid >> 6), lane = tid & 63, wr = wid >> 2, wc = wid & 3, fr = lane & 15, fq = lane >> 4;
    const int K = g.K, nt = K / BK;
    unsigned voffA[2], voffB[2];
#pragma unroll
    for (int i = 0; i < 2; ++i) { int R, C; stage_rc(tid * 16 + i * 8192, R, C); const int Rb = Epi::PERM ? ((R & ~31) + perm32(R & 31)) : R;
        voffA[i] = (unsigned)(R * K + C) * 2u; voffB[i] = (unsigned)(Rb * K + C) * 2u; }
    const size_t kstep = (size_t)(BK * 2);
    const size_t hstep = (size_t)HALF * K * 2;
    const size_t tstep = 2 * hstep;
    const unsigned ldsw = (unsigned)wid * 1024u;
    const int aoff = lds_byte(wr * 64 + fr, fq * 8), boff = lds_byte(wc * 32 + fr, fq * 8);
#define PG8_SA(b, h) (((b) * 2 + (h)) * HTB)
#define PG8_SB(b, h) ((4 + (b) * 2 + (h)) * HTB)
#define PG8_STAGE(bufoff, gbase, voff) do { _Pragma("unroll") for (int _i = 0; _i < 2; ++_i) \
        __builtin_amdgcn_global_load_lds((const unsigned*)((const char*)(gbase) + (voff)[_i]), (PG8_LAS unsigned*)(lds + (bufoff) + ldsw + _i * 8192), 16, 0, 0); } while (0)
#define PG8_LDA(dst, b, h) do { _Pragma("unroll") for (int m = 0; m < 4; ++m) _Pragma("unroll") for (int k = 0; k < 2; ++k) dst[m][k] = *(const PG8_LAS bf16x8*)(lds + PG8_SA(b, h) + aoff + m * 2048 + k * 1024); } while (0)
#define PG8_LDB(dst, b, h) do { _Pragma("unroll") for (int n = 0; n < 2; ++n) _Pragma("unroll") for (int k = 0; k < 2; ++k) dst[n][k] = *(const PG8_LAS bf16x8*)(lds + PG8_SB(b, h) + boff + n * 2048 + k * 1024); } while (0)
#define PG8_MMA(ai, bj, At, Bt) do { __builtin_amdgcn_s_setprio(1); _Pragma("unroll") for (int m = 0; m < 4; ++m) _Pragma("unroll") for (int n = 0; n < 2; ++n) _Pragma("unroll") for (int k = 0; k < 2; ++k) \
        acc[ai][bj][m][n] = __builtin_amdgcn_mfma_f32_16x16x32_bf16(Bt[n][k], At[m][k], acc[ai][bj][m][n], 0, 0, 0); __builtin_amdgcn_s_setprio(0); } while (0)
#define PG8_WAIT_V(n) asm volatile("s_waitcnt vmcnt(" #n ")" ::: "memory")
#define PG8_WAIT_L(n) asm volatile("s_waitcnt lgkmcnt(" #n ")" ::: "memory")
#define PG8_BAR __builtin_amdgcn_s_barrier()
#define PG8_SCHED __builtin_amdgcn_sched_barrier(0)
    Unit cur, nxt; int ui = 0;
    if (!S.next(0, cur)) return;
    f32x4 acc[2][2][4][2];
#pragma unroll
    for (int a = 0; a < 2; ++a)
#pragma unroll
        for (int b = 0; b < 2; ++b)
#pragma unroll
            for (int m = 0; m < 4; ++m)
#pragma unroll
                for (int n = 0; n < 2; ++n) acc[a][b][m][n] = (f32x4){0.f, 0.f, 0.f, 0.f};
    bf16x8 At[4][2], B0[2][2], B1[2][2];
    const char* cA = (const char*)g.A + (size_t)cur.pm * tstep; const char* cB = (const char*)g.Bt + (size_t)cur.pn * tstep;
    S.a_ready(cur);
    if constexpr (SP2) {
        PG8_STAGE(PG8_SB(0, 0), cB, voffB); PG8_STAGE(PG8_SB(0, 1), cB + hstep, voffB); PG8_STAGE(PG8_SA(0, 0), cA, voffA); PG8_STAGE(PG8_SA(0, 1), cA + hstep, voffA);
        if (wr == 1) PG8_BAR;
        PG8_WAIT_V(2); PG8_BAR;
        PG8_STAGE(PG8_SB(1, 0), cB + kstep, voffB); PG8_STAGE(PG8_SA(1, 0), cA + kstep, voffA); PG8_STAGE(PG8_SB(1, 1), cB + hstep + kstep, voffB);
        PG8_WAIT_V(6); PG8_BAR;
    } else {
        PG8_STAGE(PG8_SB(0, 0), cB, voffB); PG8_STAGE(PG8_SA(0, 0), cA, voffA); PG8_STAGE(PG8_SB(0, 1), cB + hstep, voffB); PG8_STAGE(PG8_SA(0, 1), cA + hstep, voffA);
        if (wr == 1) PG8_BAR;
        PG8_WAIT_V(4); PG8_BAR;
        PG8_STAGE(PG8_SB(1, 0), cB + kstep, voffB); PG8_STAGE(PG8_SA(1, 0), cA + kstep, voffA); PG8_STAGE(PG8_SB(1, 1), cB + hstep + kstep, voffB);
        PG8_WAIT_V(6); PG8_BAR;
    }
    for (;;) {
        const bool has_next = S.next(ui + 1, nxt);
        const char* nA = has_next ? (const char*)g.A + (size_t)nxt.pm * tstep : cA; const char* nB = has_next ? (const char*)g.Bt + (size_t)nxt.pn * tstep : cB;
        for (int t = 0; t < nt; t += 2) {
            const bool last = (t == nt - 2);
            const char* a1 = cA + (size_t)(t + 1) * kstep;
            const char* a2 = last ? nA : cA + (size_t)(t + 2) * kstep; const char* b2 = last ? nB : cB + (size_t)(t + 2) * kstep;
            const char* a3 = a2 + kstep; const char* b3 = b2 + kstep;
            if (last && has_next) S.a_ready(nxt);
            if constexpr (SP2) {
            PG8_LDB(B0, 0, 0); PG8_LDB(B1, 0, 1); PG8_SCHED; PG8_LDA(At, 0, 0); PG8_STAGE(PG8_SA(1, 1), a1 + hstep, voffA);
            PG8_WAIT_V(8); PG8_WAIT_L(0); PG8_BAR; PG8_MMA(0, 0, At, B0); PG8_MMA(0, 1, At, B1); PG8_BAR; PG8_SCHED;
            PG8_LDA(At, 0, 1); PG8_STAGE(PG8_SB(0, 0), b2, voffB); PG8_STAGE(PG8_SB(0, 1), b2 + hstep, voffB); PG8_STAGE(PG8_SA(0, 0), a2, voffA);
            PG8_WAIT_V(8); PG8_WAIT_L(0); PG8_BAR; PG8_MMA(1, 0, At, B0); PG8_MMA(1, 1, At, B1); PG8_BAR; PG8_SCHED;
            PG8_LDB(B0, 1, 0); PG8_LDB(B1, 1, 1); PG8_SCHED; PG8_LDA(At, 1, 0); PG8_STAGE(PG8_SA(0, 1), a2 + hstep, voffA);
            PG8_WAIT_V(8); PG8_WAIT_L(0); PG8_BAR; PG8_MMA(0, 0, At, B0); PG8_MMA(0, 1, At, B1); PG8_BAR; PG8_SCHED;
            PG8_LDA(At, 1, 1); PG8_STAGE(PG8_SB(1, 0), b3, voffB); PG8_STAGE(PG8_SB(1, 1), b3 + hstep, voffB); PG8_STAGE(PG8_SA(1, 0), a3, voffA);
            PG8_WAIT_V(8); PG8_WAIT_L(0); PG8_BAR; PG8_MMA(1, 0, At, B0); PG8_MMA(1, 1, At, B1); PG8_BAR; PG8_SCHED;
            } else {
            PG8_LDB(B0, 0, 0); PG8_SCHED; PG8_LDA(At, 0, 0); PG8_STAGE(PG8_SA(1, 1), a1 + hstep, voffA);
            PG8_WAIT_L(8); PG8_BAR; PG8_WAIT_L(0); PG8_MMA(0, 0, At, B0); PG8_BAR; PG8_SCHED;
            PG8_LDB(B1, 0, 1); PG8_STAGE(PG8_SB(0, 0), b2, voffB);
            PG8_BAR; PG8_WAIT_L(0); PG8_MMA(0, 1, At, B1); PG8_BAR;
            PG8_LDA(At, 0, 1); PG8_STAGE(PG8_SA(0, 0), a2, voffA);
            PG8_BAR; PG8_WAIT_L(0); PG8_MMA(1, 0, At, B0); PG8_BAR; PG8_SCHED;
            PG8_STAGE(PG8_SB(0, 1), b2 + hstep, voffB);
            PG8_WAIT_V(6); PG8_BAR; PG8_MMA(1, 1, At, B1); PG8_BAR;
            PG8_LDB(B0, 1, 0); PG8_SCHED; PG8_LDA(At, 1, 0); PG8_STAGE(PG8_SA(0, 1), a2 + hstep, voffA);
            PG8_WAIT_L(8); PG8_BAR; PG8_WAIT_L(0); PG8_MMA(0, 0, At, B0); PG8_BAR; PG8_SCHED;
            PG8_LDB(B1, 1, 1); PG8_STAGE(PG8_SB(1, 0), b3, voffB);
            PG8_BAR; PG8_WAIT_L(0); PG8_MMA(0, 1, At, B1); PG8_BAR;
            PG8_LDA(At, 1, 1); PG8_STAGE(PG8_SA(1, 0), a3, voffA);
            PG8_BAR; PG8_WAIT_L(0); PG8_MMA(1, 0, At, B0); PG8_BAR; PG8_SCHED;
            PG8_STAGE(PG8_SB(1, 1), b3 + hstep, voffB);
            PG8_WAIT_V(6); PG8_BAR; PG8_MMA(1, 1, At, B1); PG8_BAR;
            }
        }
        if constexpr (ALIGN_EPI) { if (wr == 0) PG8_BAR; }
        if constexpr (!Epi::AFTER_DRAIN) { E(acc, cur, wr, wc, fr, fq); S.done(cur); }
        if (!has_next) break;
#pragma unroll
        for (int a = 0; a < 2; ++a)
#pragma unroll
            for (int b = 0; b < 2; ++b)
#pragma unroll
                for (int m = 0; m < 4; ++m)
#pragma unroll
                    for (int n = 0; n < 2; ++n) acc[a][b][m][n] = (f32x4){0.f, 0.f, 0.f, 0.f};
        cur = nxt; cA = nA; cB = nB; ++ui;
        if constexpr (ALIGN_EPI) { if (wr == 1) PG8_BAR; }
    }
    PG8_WAIT_V(0);
    if constexpr (!ALIGN_EPI) { if (wr == 0) PG8_BAR; }
    PG8_BAR;
    if constexpr (Epi::AFTER_DRAIN) { E.fused(acc, cur, wr, wc, fr, fq, lds, wid, lane); S.done(cur); }
#undef PG8_SA
#undef PG8_SB
#undef PG8_STAGE
#undef PG8_LDA
#undef PG8_LDB
#undef PG8_MMA
#undef PG8_WAIT_V
#undef PG8_WAIT_L
#undef PG8_BAR
#undef PG8_SCHED
}
}


#define LAS __attribute__((address_space(3)))
typedef unsigned short bf16_t;
typedef short bf16x8 __attribute__((ext_vector_type(8)));
typedef float f32x4 __attribute__((ext_vector_type(4)));
typedef unsigned u32x4 __attribute__((ext_vector_type(4)));
typedef unsigned u32x2 __attribute__((ext_vector_type(2)));

constexpr int D = 1024, NB = 16, SEQ = 2048, TC = 256, DEPTH = 4;
constexpr int MC = NB * TC, ML = NB * SEQ, M = MC + ML;
constexpr int NIN = 2960, NINP = 3072, P1W = 1152, P2W = 1808, DFF = 4096;
constexpr int NT = 512;
constexpr int LDS_BYTES = 132096;

constexpr size_t WS_MOD = 0;
constexpr size_t WS_CTR = WS_MOD + 1835008;
constexpr size_t WS_BAR = WS_CTR + 4096;
constexpr size_t WS_ROPE = WS_MOD + 2097152;
constexpr size_t WS_XC = WS_ROPE + 524288;
constexpr size_t WS_WIN = WS_XC + (size_t)MC * D * 4;
constexpr size_t WS_WOUT = WS_WIN + (size_t)NINP * D * 2;
constexpr size_t WS_W1 = WS_WOUT + (size_t)D * D * 2;
constexpr size_t WS_W2 = WS_W1 + (size_t)DFF * D * 2;
constexpr size_t WS_H = WS_W2 + (size_t)DFF * D * 2;
constexpr size_t WS_P1 = WS_H + (size_t)M * D * 2;
constexpr size_t WS_P2 = WS_P1 + (size_t)M * P1W * 2;
constexpr size_t WS_RKV = WS_P2 + (size_t)M * P2W * 2;
constexpr size_t WS_WD = WS_RKV + (size_t)M * 768 * 2;
constexpr size_t WS_AD = WS_WD + (size_t)2 * M * 256 * 2;
constexpr size_t WS_G = WS_AD + (size_t)2 * M * 256 * 2;
constexpr size_t WS_YM = WS_G + (size_t)M * 256 * 2;
constexpr size_t WS_LW = WS_YM + (size_t)2 * M * 256 * 2;
constexpr size_t WS_RSQ1 = WS_LW + 262144;
constexpr size_t WS_RSQ2 = WS_RSQ1 + (size_t)M * 64;
constexpr size_t WS_CV1 = WS_RSQ2 + (size_t)M * 64;
constexpr size_t WS_CV2 = WS_CV1 + (size_t)17 * NINP * 4;
constexpr size_t WS_END = WS_CV2 + (size_t)17 * DFF * 4;
static_assert(WS_END <= 536870912ull, "workspace map exceeds 512 MiB");
static_assert(WS_P1 + (size_t)M * DFF * 2 <= WS_AD, "hidden overlay must end inside the dead mixer buffers");

struct Params { const float* in[29]; float* out; unsigned char* ws; int ph_lo, ph_hi; };
enum { I_X = 0, I_C, I_CTX, I_CCTX, I_ADAW, I_ADAB, I_N1G, I_N2G, I_WIN, I_WOUT, I_RCONV, I_RW0, I_RWUP, I_RA0, I_RAUP, I_RGUP, I_RKK, I_RKA, I_RRK, I_RLNW, I_RLNB,
       I_SINK, I_MCONV, I_MBI, I_MBF, I_MNG, I_W1, I_W2, I_FG };

__device__ __forceinline__ unsigned f2bf(float f) { unsigned u = __builtin_bit_cast(unsigned, f); return (u + 0x7fffu + ((u >> 16) & 1u)) >> 16; }
__device__ __forceinline__ float bf2f(unsigned b) { return __builtin_bit_cast(float, (b & 0xffffu) << 16); }
__device__ __forceinline__ float bflo(unsigned w) { return __builtin_bit_cast(float, w << 16); }
__device__ __forceinline__ float bfhi(unsigned w) { return __builtin_bit_cast(float, w & 0xffff0000u); }
__device__ __forceinline__ unsigned pk2(float lo, float hi) { unsigned r; asm("v_cvt_pk_bf16_f32 %0, %1, %2" : "=v"(r) : "v"(lo), "v"(hi)); return r; }
__device__ __forceinline__ float sigmoidf_(float x) { return __builtin_amdgcn_rcpf(1.f + __expf(-x)); }
__device__ __forceinline__ float row16_sum(float v);
__device__ __forceinline__ float wave_sum(float v) { v = row16_sum(v); v += __shfl_xor(v, 16); v += __shfl_xor(v, 32); return v; }
template <int CTRL> __device__ __forceinline__ float dpp_f(float v) { return __builtin_bit_cast(float, __builtin_amdgcn_update_dpp(0, __builtin_bit_cast(int, v), CTRL, 0xf, 0xf, true)); }
__device__ __forceinline__ float row16_sum(float v) { v += dpp_f<0xB1>(v); v += dpp_f<0x4E>(v); v += dpp_f<0x124>(v); v += dpp_f<0x128>(v); return v; }
__device__ __forceinline__ float row8_sum(float v) { v += dpp_f<0xB1>(v); v += dpp_f<0x4E>(v); v += dpp_f<0x141>(v); return v; }
typedef float f32x2 __attribute__((ext_vector_type(2)));
#define LDS_WAIT() asm volatile("s_waitcnt lgkmcnt(0)" ::: "memory")
__device__ __forceinline__ void unpack8(const u32x4 w, float (&f)[8]) {
    f[0] = bflo(w.x); f[1] = bfhi(w.x); f[2] = bflo(w.y); f[3] = bfhi(w.y); f[4] = bflo(w.z); f[5] = bfhi(w.z); f[6] = bflo(w.w); f[7] = bfhi(w.w);
}
__device__ __forceinline__ u32x4 pack8(const float (&f)[8]) { u32x4 o; o.x = pk2(f[0], f[1]); o.y = pk2(f[2], f[3]); o.z = pk2(f[4], f[5]); o.w = pk2(f[6], f[7]); return o; }
__device__ __forceinline__ float h2f(unsigned bits) { return (float)__builtin_bit_cast(_Float16, (unsigned short)bits); }
__device__ __forceinline__ unsigned f2h(float f) { return (unsigned)__builtin_bit_cast(unsigned short, (_Float16)f); }

__device__ __forceinline__ int chain_row(int b, int dir, int n) {
    if (n < TC) { const int t = dir ? (TC - 1 - n) : n; return b * TC + t; }
    int s = n - TC; s = dir ? (SEQ - 1 - s) : s; return MC + b * SEQ + s;
}

__device__ __forceinline__ void epi_row_scales(const float* rsq, int rowbase, int fq, float (&rs)[2][4]) {
    f32x4 q[2][4];
#pragma unroll
    for (int ai = 0; ai < 2; ++ai)
#pragma unroll
        for (int m = 0; m < 4; ++m) q[ai][m] = *(const f32x4*)(rsq + (size_t)(rowbase + ai * 128 + m * 16) * 16 + 4 * fq);
#pragma unroll
    for (int ai = 0; ai < 2; ++ai)
#pragma unroll
        for (int m = 0; m < 4; ++m) { float t = (q[ai][m][0] + q[ai][m][1]) + (q[ai][m][2] + q[ai][m][3]); t += __shfl_xor(t, 16); t += __shfl_xor(t, 32); rs[ai][m] = rsqrtf(t * (1.f / D) + 1e-6f); }
}
struct EpiIn {
    static constexpr bool PERM = true, AFTER_DRAIN = false;
    bf16_t* P1; bf16_t* P2; const float* rsq; const float* cv;
    __device__ __forceinline__ void operator()(const f32x4 (&acc)[2][2][4][2], const pg8::Unit& u, int wr, int wc, int fr, int fq) const {
        const int row0 = u.pm * 256 + wr * 64 + fr, col0 = u.pn * 256 + wc * 32 + 8 * fq;
        const int rowu = u.pm * 256; const float* cvp = cv + (size_t)(rowu < MC ? 16 : ((rowu - MC) >> 11)) * NINP + col0;
        f32x4 c4[2][2];
#pragma unroll
        for (int bj = 0; bj < 2; ++bj)
#pragma unroll
            for (int n = 0; n < 2; ++n) c4[bj][n] = *(const f32x4*)(cvp + bj * 128 + n * 4);
        float rsv[2][4]; epi_row_scales(rsq, row0, fq, rsv);
#pragma unroll
        for (int ai = 0; ai < 2; ++ai)
#pragma unroll
            for (int m = 0; m < 4; ++m) { const int rowi = row0 + ai * 128 + m * 16; const size_t row = (size_t)rowi;
                const float rs = rsv[ai][m];
#pragma unroll
                for (int bj = 0; bj < 2; ++bj) { const int col = col0 + bj * 128; const f32x4 v0 = acc[ai][bj][m][0] * rs + c4[bj][0], v1 = acc[ai][bj][m][1] * rs + c4[bj][1];
                    u32x4 o; o.x = pk2(v0[0], v0[1]); o.y = pk2(v0[2], v0[3]); o.z = pk2(v1[0], v1[1]); o.w = pk2(v1[2], v1[3]);
                    if (col < P1W) *(u32x4*)(P1 + row * P1W + col) = o;
                    else if (col < NIN) *(u32x4*)(P2 + row * P2W + (col - P1W)) = o; } }
    }
};
struct EpiRes {
    static constexpr bool PERM = true, AFTER_DRAIN = false;
    float* Xc; float* Xl; const float* modl; int gate_idx; int row_off;
    bf16_t* Hn; float* rsq; const float* gn; const float* modn; int sc_idx;
    __device__ __forceinline__ void operator()(const f32x4 (&acc)[2][2][4][2], const pg8::Unit& u, int wr, int wc, int fr, int fq) const {
        const int row0 = row_off + u.pm * 256 + wr * 64 + fr, col0 = u.pn * 256 + wc * 32 + 8 * fq;
        const int rowu = row_off + u.pm * 256, bi = rowu < MC ? 16 : ((rowu - MC) >> 11);
        const float* gp = modl + (size_t)bi * 6144 + gate_idx * 1024 + col0;
        f32x4 g4[2][2], s4[2][2];
#pragma unroll
        for (int bj = 0; bj < 2; ++bj)
#pragma unroll
            for (int n = 0; n < 2; ++n) { g4[bj][n] = *(const f32x4*)(gp + bj * 128 + n * 4);
                s4[bj][n] = *(const f32x4*)(gn + col0 + bj * 128 + n * 4) * (*(const f32x4*)(modn + (size_t)bi * 6144 + sc_idx * 1024 + col0 + bj * 128 + n * 4) + 1.f); }
        float* xb = (rowu < MC ? Xc + (size_t)row0 * D : Xl + (size_t)(row0 - MC) * D) + col0;
#pragma unroll
        for (int am = 0; am < 4; ++am) { const int ai = am >> 1, mb = (am & 1) * 2;
            f32x4 xv[2][2][2];
#pragma unroll
            for (int m = 0; m < 2; ++m)
#pragma unroll
                for (int bj = 0; bj < 2; ++bj)
#pragma unroll
                    for (int n = 0; n < 2; ++n) xv[m][bj][n] = *(const f32x4*)(xb + (size_t)(ai * 128 + (mb + m) * 16) * D + bj * 128 + n * 4);
            asm volatile("s_waitcnt vmcnt(0)" ::: "memory");
#pragma unroll
            for (int m = 0; m < 2; ++m) { const int row = row0 + ai * 128 + (mb + m) * 16; float* xp = xb + (size_t)(ai * 128 + (mb + m) * 16) * D;
                float ss = 0.f;
#pragma unroll
                for (int bj = 0; bj < 2; ++bj) { const int co = bj * 128;
                    const f32x4 x0 = xv[m][bj][0] + g4[bj][0] * acc[ai][bj][mb + m][0], x1 = xv[m][bj][1] + g4[bj][1] * acc[ai][bj][mb + m][1];
                    *(f32x4*)(xp + co) = x0; *(f32x4*)(xp + co + 4) = x1;
                    const f32x4 h0 = x0 * s4[bj][0], h1 = x1 * s4[bj][1]; u32x4 o; o.x = pk2(h0[0], h0[1]); o.y = pk2(h0[2], h0[3]); o.z = pk2(h1[0], h1[1]); o.w = pk2(h1[2], h1[3]);
                    *(u32x4*)(Hn + (size_t)row * D + col0 + co) = o;
                    ss += ((x0[0] * x0[0] + x0[1] * x0[1]) + (x0[2] * x0[2] + x0[3] * x0[3])) + ((x1[0] * x1[0] + x1[1] * x1[1]) + (x1[2] * x1[2] + x1[3] * x1[3])); }
                ss += __shfl_xor(ss, 16); ss += __shfl_xor(ss, 32); if (fq == 0) rsq[(size_t)row * 16 + u.pn * 4 + wc] = ss; }
        }
    }
};
struct EpiSq {
    static constexpr bool PERM = true, AFTER_DRAIN = false;
    bf16_t* Hd; const float* rsq; const float* cv; int row_off;
    __device__ __forceinline__ void operator()(const f32x4 (&acc)[2][2][4][2], const pg8::Unit& u, int wr, int wc, int fr, int fq) const {
        const int row0 = u.pm * 256 + wr * 64 + fr, col0 = u.pn * 256 + wc * 32 + 8 * fq;
        const int rowu = row_off + u.pm * 256; const float* cvp = cv + (size_t)(rowu < MC ? 16 : ((rowu - MC) >> 11)) * DFF + col0;
        f32x4 c4[2][2];
#pragma unroll
        for (int bj = 0; bj < 2; ++bj)
#pragma unroll
            for (int n = 0; n < 2; ++n) c4[bj][n] = *(const f32x4*)(cvp + bj * 128 + n * 4);
        float rsv[2][4]; epi_row_scales(rsq, row0 + row_off, fq, rsv);
#pragma unroll
        for (int ai = 0; ai < 2; ++ai)
#pragma unroll
            for (int m = 0; m < 4; ++m) { const int rel = row0 + ai * 128 + m * 16; bf16_t* rp = Hd + (size_t)rel * DFF + col0;
                const float rs = rsv[ai][m];
#pragma unroll
                for (int bj = 0; bj < 2; ++bj) { f32x4 v0 = acc[ai][bj][m][0] * rs + c4[bj][0], v1 = acc[ai][bj][m][1] * rs + c4[bj][1];
#pragma unroll
                    for (int j = 0; j < 4; ++j) { const float r0 = v0[j] > 0.f ? v0[j] : 0.f, r1 = v1[j] > 0.f ? v1[j] : 0.f; v0[j] = r0 * r0; v1[j] = r1 * r1; }
                    u32x4 o; o.x = pk2(v0[0], v0[1]); o.y = pk2(v0[2], v0[3]); o.z = pk2(v1[0], v1[1]); o.w = pk2(v1[2], v1[3]); *(u32x4*)(rp + bj * 128) = o; } }
    }
};

__device__ __forceinline__ void phase_adaln(const Params& p, LAS unsigned char* lds, int bid, int G) {
    const int tid = opaque_tid(), wave = tid >> 6, lane = tid & 63;
    LAS float* sc = (LAS float*)lds;
    LAS float* red = sc + 17 * 1024;
    float* MOD = (float*)(p.ws + WS_MOD);
    if (bid == 0 && tid < 256) ((unsigned*)(p.ws + WS_CTR))[tid] = 0u;
    for (int i = tid; i < 17 * 1024; i += NT) { const int bi = i >> 10, k = i & 1023; const float c = bi < 16 ? p.in[I_C][bi * 1024 + k] : p.in[I_CCTX][k]; sc[i] = c * sigmoidf_(c); }
    __syncthreads();
    for (int item = bid; item < 384; item += G) {
        const int l = item / 96, j0 = (item % 96) * 64;
        float acc[17];
#pragma unroll
        for (int bi = 0; bi < 17; ++bi) acc[bi] = 0.f;
        const float* w = p.in[I_ADAW] + ((size_t)l * 1024 + wave * 128) * 6144 + j0 + lane;
        for (int k0 = 0; k0 < 128; k0 += 16) { float a[16];
#pragma unroll
            for (int j = 0; j < 16; ++j) a[j] = __builtin_nontemporal_load(w + (size_t)(k0 + j) * 6144);
#pragma unroll
            for (int j = 0; j < 16; ++j) { const int k = wave * 128 + k0 + j;
#pragma unroll
                for (int bi = 0; bi < 17; ++bi) acc[bi] += sc[bi * 1024 + k] * a[j]; } }
#pragma unroll
        for (int bi = 0; bi < 17; ++bi) red[(wave * 17 + bi) * 64 + lane] = acc[bi];
        __syncthreads();
        for (int i = tid; i < 17 * 64; i += NT) { const int bi = i >> 6, ln = i & 63; float s = 0.f;
#pragma unroll
            for (int w8 = 0; w8 < 8; ++w8) s += red[(w8 * 17 + bi) * 64 + ln];
            MOD[((size_t)l * 17 + bi) * 6144 + j0 + ln] = s + p.in[I_ADAB][l * 6144 + j0 + ln]; }
        __syncthreads();
    }
    float* ROPE = (float*)(p.ws + WS_ROPE);
    for (int idx = bid * NT + tid; idx < SEQ * 32; idx += G * NT) { const int pos = idx >> 5, i = idx & 31, f = i & 15;
        const float inv = powf(10000.f, -(float)f / 16.f); const float ang = (float)(i < 16 ? (pos >> 6) : (pos & 63)) * inv;
        const float n = rintf(ang * 0.15915494309189535f); float r = fmaf(-n, 6.28318548202514648f, ang); r = fmaf(-n, -1.7484555e-7f, r);
        ROPE[2 * idx] = cosf(r); ROPE[2 * idx + 1] = sinf(r); }
}

__device__ __forceinline__ void transpose_item(const float* W, int K, int N, bf16_t* WT, LAS float* scr, int item, int lane) {
    const int nblk = (N + 31) / 32, kb = item / nblk, nb = item % nblk, k0 = 64 * kb, n0 = 32 * nb;
    const int nn = n0 + (lane & 31); const bool ok = nn < N;
#pragma unroll 8
    for (int i = 0; i < 32; ++i) { const int kk = 2 * i + (lane >> 5); scr[kk * 33 + (lane & 31)] = ok ? W[(size_t)(k0 + kk) * N + nn] : 0.f; }
    LDS_WAIT();
    const int c = lane & 7;
#pragma unroll
    for (int j = 0; j < 4; ++j) { const int n = (lane >> 3) + 8 * j; const LAS float* s = scr + (8 * c) * 33 + n;
        u32x4 o; o.x = pk2(s[0 * 33], s[1 * 33]); o.y = pk2(s[2 * 33], s[3 * 33]); o.z = pk2(s[4 * 33], s[5 * 33]); o.w = pk2(s[6 * 33], s[7 * 33]);
        *(u32x4*)(WT + (size_t)(n0 + n) * K + k0 + 8 * c) = o; }
    LDS_WAIT();
}
constexpr int CW_I1 = 16 * 93, CW_I2 = 16 * 32, CW_I3 = 16 * 128, CW_I4 = 64 * 32, CW_I123 = CW_I1 + CW_I2 + CW_I3, CW_ITOT = CW_I123 + CW_I4;
__device__ __forceinline__ void convert_weights(const Params& p, int l, LAS unsigned char* lds, int it_lo, int it_hi, int bi, int ncb) {
    const int tid = opaque_tid(), wave = tid >> 6, lane = tid & 63;
    LAS float* scr = (LAS float*)(lds + wave * 8448);
    for (int it = bi < ncb ? it_lo + bi * 8 + wave : it_hi; it < it_hi; it += ncb * 8) {
        int r = it;
        if (r < CW_I1) { transpose_item(p.in[I_WIN] + (size_t)l * D * NIN, D, NIN, (bf16_t*)(p.ws + WS_WIN), scr, r, lane); continue; } r -= CW_I1;
        if (r < CW_I2) { transpose_item(p.in[I_WOUT] + (size_t)l * D * D, D, D, (bf16_t*)(p.ws + WS_WOUT), scr, r, lane); continue; } r -= CW_I2;
        if (r < CW_I3) { transpose_item(p.in[I_W1] + (size_t)l * D * DFF, D, DFF, (bf16_t*)(p.ws + WS_W1), scr, r, lane); continue; } r -= CW_I3;
        transpose_item(p.in[I_W2] + (size_t)l * DFF * D, DFF, D, (bf16_t*)(p.ws + WS_W2), scr, r, lane);
    }
}

__device__ __forceinline__ void phase_norm(const Params& p, int l, int which, int row_lo, int bid, int G) {
    const int tid = opaque_tid(), wave = tid >> 6, lane = tid & 63;
    const float* MOD = (const float*)(p.ws + WS_MOD) + (size_t)l * 17 * 6144;
    float* Xc = (float*)(p.ws + WS_XC); bf16_t* H = (bf16_t*)(p.ws + WS_H);
    const float* gsrc = (which ? p.in[I_N2G] : p.in[I_N1G]) + l * D;
    const bool first = (l == 0 && which == 0);
    for (int row = row_lo + bid * 8 + wave; row < M; row += G * 8) {
        const float* src = first ? (row < MC ? p.in[I_CTX] + (size_t)row * D : p.in[I_X] + (size_t)(row - MC) * D)
                                 : (row < MC ? Xc + (size_t)row * D : p.out + (size_t)(row - MC) * D);
        f32x4 v[4]; float ss = 0.f;
#pragma unroll
        for (int j = 0; j < 4; ++j) { v[j] = *(const f32x4*)(src + 4 * lane + 256 * j); ss += v[j][0] * v[j][0] + v[j][1] * v[j][1] + v[j][2] * v[j][2] + v[j][3] * v[j][3]; }
        ss = wave_sum(ss); const float rs = rsqrtf(ss * (1.f / D) + 1e-6f);
        if (first) { float* dst = row < MC ? Xc + (size_t)row * D : p.out + (size_t)(row - MC) * D;
#pragma unroll
            for (int j = 0; j < 4; ++j) *(f32x4*)(dst + 4 * lane + 256 * j) = v[j]; }
        const int bi = row < MC ? 16 : ((row - MC) >> 11);
        const float* sh = MOD + (size_t)bi * 6144 + (which ? 3 : 0) * 1024; const float* scl = sh + 1024;
#pragma unroll
        for (int j = 0; j < 4; ++j) { const int col = 4 * lane + 256 * j;
            const f32x4 g = *(const f32x4*)(gsrc + col), s1 = *(const f32x4*)(scl + col), s0 = *(const f32x4*)(sh + col);
            float y[4];
#pragma unroll
            for (int e = 0; e < 4; ++e) y[e] = (v[j][e] * rs * g[e]) * (1.f + s1[e]) + s0[e];
            u32x2 o; o.x = pk2(y[0], y[1]); o.y = pk2(y[2], y[3]); *(u32x2*)(H + (size_t)row * D + col) = o; }
    }
}
__device__ __forceinline__ void phase_cvec(const Params& p, int l, LAS unsigned char* lds, int bid, int G) {
    const int tid = opaque_tid(), wave = tid >> 6, lane = tid & 63;
    LAS float* sc = (LAS float*)lds; LAS float* red = sc + 17 * 1024;
    const float* MODl = (const float*)(p.ws + WS_MOD) + (size_t)l * 17 * 6144;
    for (int item = G - 1 - bid; item < 111; item += G) {
        const bool second = item >= 47; const int j0 = (second ? item - 47 : item) * 64, N = second ? DFF : NIN, ldo = second ? DFF : NINP;
        const float* W = second ? p.in[I_W1] + (size_t)l * D * DFF : p.in[I_WIN] + (size_t)l * D * NIN;
        float* out = (float*)(p.ws + (second ? WS_CV2 : WS_CV1));
        __syncthreads();
        for (int i = tid; i < 17 * 1024; i += NT) { const int bi = i >> 10, k = i & 1023; sc[i] = MODl[(size_t)bi * 6144 + (second ? 3 : 0) * 1024 + k]; }
        __syncthreads();
        float acc[17];
#pragma unroll
        for (int bi = 0; bi < 17; ++bi) acc[bi] = 0.f;
        const int n = j0 + lane; const bool ok = n < N;
        for (int k0 = 0; k0 < 128; k0 += 16) { float a[16];
#pragma unroll
            for (int j = 0; j < 16; ++j) a[j] = ok ? W[(size_t)(wave * 128 + k0 + j) * N + n] : 0.f;
#pragma unroll
            for (int j = 0; j < 16; ++j) { const int k = wave * 128 + k0 + j;
#pragma unroll
                for (int bi = 0; bi < 17; ++bi) acc[bi] += sc[bi * 1024 + k] * a[j]; } }
#pragma unroll
        for (int bi = 0; bi < 17; ++bi) red[(wave * 17 + bi) * 64 + lane] = acc[bi];
        __syncthreads();
        for (int i = tid; i < 17 * 64; i += NT) { const int bi = i >> 6, ln = i & 63; float sum = 0.f;
#pragma unroll
            for (int w8 = 0; w8 < 8; ++w8) sum += red[(w8 * 17 + bi) * 64 + ln];
            if (j0 + ln < N) out[(size_t)bi * ldo + j0 + ln] = sum; }
    }
    __syncthreads();
}
__device__ __forceinline__ void phase_boot(const Params& p, int bid, int G) {
    const int tid = opaque_tid(), wave = tid >> 6, lane = tid & 63;
    const float* MOD = (const float*)(p.ws + WS_MOD);
    float* Xc = (float*)(p.ws + WS_XC); bf16_t* H = (bf16_t*)(p.ws + WS_H); float* rsq = (float*)(p.ws + WS_RSQ1);
    for (int row = bid * 8 + wave; row < M; row += G * 8) {
        const float* src = row < MC ? p.in[I_CTX] + (size_t)row * D : p.in[I_X] + (size_t)(row - MC) * D;
        float* dst = row < MC ? Xc + (size_t)row * D : p.out + (size_t)(row - MC) * D;
        const float* scl = MOD + (size_t)(row < MC ? 16 : ((row - MC) >> 11)) * 6144 + 1024;
        float ss = 0.f;
#pragma unroll
        for (int j = 0; j < 4; ++j) { const int col = 4 * lane + 256 * j; const f32x4 v = *(const f32x4*)(src + col); *(f32x4*)(dst + col) = v;
            ss += (v[0] * v[0] + v[1] * v[1]) + (v[2] * v[2] + v[3] * v[3]);
            const f32x4 g = *(const f32x4*)(p.in[I_N1G] + col), s1 = *(const f32x4*)(scl + col); const f32x4 hv = v * (g * (s1 + 1.f));
            u32x2 o; o.x = pk2(hv[0], hv[1]); o.y = pk2(hv[2], hv[3]); *(u32x2*)(H + (size_t)row * D + col) = o; }
        ss = wave_sum(ss); if (lane < 16) rsq[(size_t)row * 16 + lane] = lane == 0 ? ss : 0.f;
    }
}
__device__ __forceinline__ void zero_f32(float* ptr, int n, int bid, int G) { for (int i = bid * NT + opaque_tid(); i < n; i += G * NT) ptr[i] = 0.f; }
__device__ __forceinline__ void phase_final(const Params& p, int bid, int G) {
    const int tid = opaque_tid(), wave = tid >> 6, lane = tid & 63;
    for (int row = bid * 8 + wave; row < ML; row += G * 8) { float* xr = p.out + (size_t)row * D;
        f32x4 v[4]; float ss = 0.f;
#pragma unroll
        for (int j = 0; j < 4; ++j) { v[j] = *(const f32x4*)(xr + 4 * lane + 256 * j); ss += v[j][0] * v[j][0] + v[j][1] * v[j][1] + v[j][2] * v[j][2] + v[j][3] * v[j][3]; }
        ss = wave_sum(ss); const float rs = rsqrtf(ss * (1.f / D) + 1e-6f);
#pragma unroll
        for (int j = 0; j < 4; ++j) { const int col = 4 * lane + 256 * j; const f32x4 g = *(const f32x4*)(p.in[I_FG] + col);
            f32x4 o; o[0] = v[j][0] * rs * g[0]; o[1] = v[j][1] * rs * g[1]; o[2] = v[j][2] * rs * g[2]; o[3] = v[j][3] * rs * g[3]; *(f32x4*)(xr + col) = o; }
    }
}

__device__ __forceinline__ void convert_lora(const Params& p, int l, int bid, int G) {
    const int tid = opaque_tid(); bf16_t* LW = (bf16_t*)(p.ws + WS_LW);
    for (int idx = bid * NT + tid; idx < 98304; idx += G * NT) { float v;
        if (idx < 65536) { const int sub = idx >> 14, n = (idx >> 6) & 255, k = idx & 63;
            v = (sub < 2 ? p.in[I_RWUP] + ((size_t)l * 2 + sub) * 16384 : p.in[I_RAUP] + ((size_t)l * 2 + (sub - 2)) * 16384)[k * 256 + n]; }
        else { const int j = idx - 65536, n = j >> 7, k = j & 127; v = p.in[I_RGUP][(size_t)l * 32768 + k * 256 + n]; }
        LW[idx] = (bf16_t)f2bf(v); }
}
__device__ __forceinline__ void phase_prep(const Params& p, int l, LAS unsigned char* lds, int bid, int G) {
    const int tid = opaque_tid(), wave = tid >> 6, lane = tid & 63, fr = lane & 15, fq = lane >> 4;
    constexpr int PTR = 144;
    const bf16_t* P1 = (const bf16_t*)(p.ws + WS_P1); const bf16_t* LW = (const bf16_t*)(p.ws + WS_LW);
    bf16_t* RKV = (bf16_t*)(p.ws + WS_RKV); unsigned short* WD = (unsigned short*)(p.ws + WS_WD); bf16_t* AD = (bf16_t*)(p.ws + WS_AD); bf16_t* Gb = (bf16_t*)(p.ws + WS_G);
    LAS bf16_t* At = (LAS bf16_t*)lds;
    LAS bf16_t* Bt = (LAS bf16_t*)(lds + PTR * 136 * 2);
    LAS float* bias_s = (LAS float*)(lds + PTR * 136 * 2 + 256 * 136 * 2);
    const float* cw = p.in[I_RCONV] + (size_t)l * 3 * 768;
    for (int tile = bid; tile < M / PTR; tile += G) {
        const int row0 = tile * PTR;
        if (tid < 480) { const int c = (tid % 96) * 8, seg = tid / 96; const int rb = seg * 29, re = rb + 29 < PTR ? rb + 29 : PTR;
            float w0[8], w1[8], w2[8];
#pragma unroll
            for (int e = 0; e < 8; ++e) { w0[e] = cw[c + e]; w1[e] = cw[768 + c + e]; w2[e] = cw[1536 + c + e]; }
            const u32x4 z4 = {0u, 0u, 0u, 0u};
            for (int r0 = rb; r0 < re; r0 += 8) {
                u32x4 rw[10];
#pragma unroll
                for (int j = 0; j < 10; ++j) { const int row = row0 + r0 - 1 + j; rw[j] = (row >= 0 && row < M && r0 - 1 + j <= re) ? *(const u32x4*)(P1 + (size_t)row * P1W + c) : z4; }
#pragma unroll
                for (int j = 0; j < 8; ++j) { const int row = row0 + r0 + j;
                    if (r0 + j < re) { const int pos = row < MC ? (row & 255) : ((row - MC) & 2047), len = row < MC ? 256 : 2048;
                        float a[8], b[8], d[8], o[8]; unpack8(pos > 0 ? rw[j] : z4, a); unpack8(rw[j + 1], b); unpack8(pos < len - 1 ? rw[j + 2] : z4, d);
#pragma unroll
                        for (int e = 0; e < 8; ++e) o[e] = a[e] * w0[e] + b[e] * w1[e] + d[e] * w2[e];
                        *(u32x4*)(RKV + (size_t)row * 768 + c) = pack8(o); } } } }
        for (int sub = 0; sub < 5; ++sub) {
            const int K = sub < 4 ? 64 : 128, pitch = K + 8, k8 = K / 8;
            const int zoff = 768 + (sub < 2 ? sub * 64 : (sub < 4 ? 128 + (sub - 2) * 64 : 256));
            const bf16_t* Bsrc = LW + (sub < 4 ? sub * 16384 : 65536);
            __syncthreads();
            for (int i0 = tid; i0 < PTR * k8; i0 += 3 * NT) {
                u32x4 zz[3];
#pragma unroll
                for (int j = 0; j < 3; ++j) { const int i = i0 + j * NT; const int r = i / k8, kc = (i % k8) * 8;
                    zz[j] = i < PTR * k8 ? *(const u32x4*)(P1 + (size_t)(row0 + r) * P1W + zoff + kc) : (u32x4){0u, 0u, 0u, 0u}; }
#pragma unroll
                for (int j = 0; j < 3; ++j) { const int i = i0 + j * NT; if (i < PTR * k8) { const int r = i / k8, kc = (i % k8) * 8; float f[8]; unpack8(zz[j], f);
                    if (sub < 2) {
#pragma unroll
                        for (int e = 0; e < 8; ++e) { const float ex = __expf(2.f * f[e]); f[e] = 1.f - 2.f * __builtin_amdgcn_rcpf(ex + 1.f); }
                    } else if (sub == 4) {
#pragma unroll
                        for (int e = 0; e < 8; ++e) f[e] = sigmoidf_(f[e]);
                    }
                    *(LAS u32x4*)(At + r * pitch + kc) = pack8(f); } } }
            for (int i0 = tid; i0 < 256 * k8; i0 += 4 * NT) { u32x4 bb[4];
#pragma unroll
                for (int j = 0; j < 4; ++j) { const int i = i0 + j * NT; bb[j] = *(const u32x4*)(Bsrc + (size_t)(i / k8) * K + (i % k8) * 8); }
#pragma unroll
                for (int j = 0; j < 4; ++j) { const int i = i0 + j * NT; *(LAS u32x4*)(Bt + (i / k8) * pitch + (i % k8) * 8) = bb[j]; } }
            if (tid < 256 && sub < 4) bias_s[tid] = (sub < 2 ? p.in[I_RW0] + ((size_t)l * 2 + sub) * 256 : p.in[I_RA0] + ((size_t)l * 2 + (sub - 2)) * 256)[tid];
            __syncthreads();
            for (int it = wave * 9; it < wave * 9 + 9; ++it) { const int mt = it >> 3, ng = it & 7;
                bf16x8 af[4];
#pragma unroll
                for (int kk = 0; kk < 4; ++kk) if (kk * 32 < K) af[kk] = *(const LAS bf16x8*)(At + (mt * 16 + fr) * pitch + kk * 32 + fq * 8);
                const int row = row0 + mt * 16 + fr;
#pragma unroll
                for (int n2 = 0; n2 < 2; ++n2) { const int nt = ng * 2 + n2;
                    f32x4 acc = {0.f, 0.f, 0.f, 0.f};
#pragma unroll
                    for (int kk = 0; kk < 4; ++kk) if (kk * 32 < K) { const bf16x8 bfr = *(const LAS bf16x8*)(Bt + (nt * 16 + fr) * pitch + kk * 32 + fq * 8);
                        acc = __builtin_amdgcn_mfma_f32_16x16x32_bf16(bfr, af[kk], acc, 0, 0, 0); }
                    const int col = nt * 16 + 4 * fq;
                    if (sub < 2) { const f32x4 w0 = *(const LAS f32x4*)(bias_s + col); unsigned h[4];
#pragma unroll
                        for (int j = 0; j < 4; ++j) h[j] = f2h(__expf(-0.606531f * sigmoidf_(w0[j] + acc[j])));
                        u32x2 o; o.x = h[0] | (h[1] << 16); o.y = h[2] | (h[3] << 16); *(u32x2*)(WD + ((size_t)sub * M + row) * 256 + col) = o;
                    } else if (sub < 4) { const f32x4 a0 = *(const LAS f32x4*)(bias_s + col);
                        u32x2 o; o.x = pk2(sigmoidf_(a0[0] + acc[0]), sigmoidf_(a0[1] + acc[1])); o.y = pk2(sigmoidf_(a0[2] + acc[2]), sigmoidf_(a0[3] + acc[3]));
                        *(u32x2*)(AD + ((size_t)(sub - 2) * M + row) * 256 + col) = o;
                    } else { u32x2 o; o.x = pk2(acc[0], acc[1]); o.y = pk2(acc[2], acc[3]); *(u32x2*)(Gb + (size_t)row * 256 + col) = o; }
                }
            }
        }
        __syncthreads();
    }
}

__device__ __forceinline__ void rwkv_chain(const Params& p, int l, int chain, LAS unsigned char* lds) {
    const int tid = opaque_tid();
    const int b = chain >> 3, h = (chain >> 1) & 3, dir = chain & 1;
    constexpr int CH = 32, NCH = (TC + SEQ) / CH, ASZ = CH * 64, BSZ = 6 * ASZ;
    LAS float* base = (LAS float*)lds;
    LAS float* ybuf = base + 2 * BSZ;
    const bf16_t* RKV = (const bf16_t*)(p.ws + WS_RKV); const unsigned short* WD = (const unsigned short*)(p.ws + WS_WD) + (size_t)dir * M * 256;
    const bf16_t* AD = (const bf16_t*)(p.ws + WS_AD) + (size_t)dir * M * 256;
    float* YR = (float*)(p.ws + WS_H) + (size_t)dir * M * 256;
    const bool producer = tid >= 256;
    const int tk = (tid >> 3) & 31, c8 = (tid & 7) * 8, ch = h * 64 + c8;
    float kkw[8], kaw[8];
#pragma unroll
    for (int e = 0; e < 8; ++e) { kkw[e] = p.in[I_RKK][l * 256 + ch + e]; kaw[e] = p.in[I_RKA][l * 256 + ch + e]; }
    const int kj = tid & 7, vg = (tid >> 3) & 31;
    f32x4 S0a = {0.f, 0.f, 0.f, 0.f}, S0b = S0a, S1a = S0a, S1b = S0a;
#define RW_STAGE(ci_) { const size_t row = (size_t)chain_row(b, dir, (ci_) * CH + tk); \
        const u32x4 rr = *(const u32x4*)(RKV + row * 768 + ch), rk = *(const u32x4*)(RKV + row * 768 + 256 + ch), rv = *(const u32x4*)(RKV + row * 768 + 512 + ch), \
                    ra = *(const u32x4*)(AD + row * 256 + ch), rw = *(const u32x4*)(WD + row * 256 + ch); \
        LAS float* Rs = base + ((ci_) & 1) * BSZ; LAS float* Ws = Rs + ASZ; LAS float* KDs = Ws + ASZ; LAS float* KKs = KDs + ASZ; LAS float* Bs = KKs + ASZ; LAS float* Vs = Bs + ASZ; \
        float r[8], k[8], vv[8], a[8], w[8], kx[8]; unpack8(rr, r); unpack8(rk, k); unpack8(rv, vv); unpack8(ra, a); \
        w[0] = h2f(rw.x & 0xffffu); w[1] = h2f(rw.x >> 16); w[2] = h2f(rw.y & 0xffffu); w[3] = h2f(rw.y >> 16); w[4] = h2f(rw.z & 0xffffu); w[5] = h2f(rw.z >> 16); w[6] = h2f(rw.w & 0xffffu); w[7] = h2f(rw.w >> 16); \
        float ss = 0.f; \
        _Pragma("unroll") for (int e = 0; e < 8; ++e) { kx[e] = k[e] * kkw[e]; ss += kx[e] * kx[e]; } \
        ss = row8_sum(ss); \
        const float inv = rsqrtf(ss + 1e-12f); \
        float kd[8], kk[8], bb[8]; \
        _Pragma("unroll") for (int e = 0; e < 8; ++e) { kk[e] = kx[e] * inv; kd[e] = k[e] * (1.f + (a[e] - 1.f) * kaw[e]); bb[e] = kk[e] * a[e]; } \
        const int o = tk * 64 + c8; \
        *(LAS f32x4*)(Rs + o) = (f32x4){r[0], r[1], r[2], r[3]}; *(LAS f32x4*)(Rs + o + 4) = (f32x4){r[4], r[5], r[6], r[7]}; \
        *(LAS f32x4*)(Ws + o) = (f32x4){w[0], w[1], w[2], w[3]}; *(LAS f32x4*)(Ws + o + 4) = (f32x4){w[4], w[5], w[6], w[7]}; \
        *(LAS f32x4*)(KDs + o) = (f32x4){kd[0], kd[1], kd[2], kd[3]}; *(LAS f32x4*)(KDs + o + 4) = (f32x4){kd[4], kd[5], kd[6], kd[7]}; \
        *(LAS f32x4*)(KKs + o) = (f32x4){kk[0], kk[1], kk[2], kk[3]}; *(LAS f32x4*)(KKs + o + 4) = (f32x4){kk[4], kk[5], kk[6], kk[7]}; \
        *(LAS f32x4*)(Bs + o) = (f32x4){bb[0], bb[1], bb[2], bb[3]}; *(LAS f32x4*)(Bs + o + 4) = (f32x4){bb[4], bb[5], bb[6], bb[7]}; \
        *(LAS f32x4*)(Vs + o) = (f32x4){vv[0], vv[1], vv[2], vv[3]}; *(LAS f32x4*)(Vs + o + 4) = (f32x4){vv[4], vv[5], vv[6], vv[7]}; }
#define RW_FLUSH(cf_) { const int rowf = chain_row(b, dir, (cf_) * CH + tk); const LAS float* ys = ybuf + ((cf_) & 1) * ASZ + tk * 64 + c8; \
        const f32x4 y0 = *(const LAS f32x4*)ys, y1 = *(const LAS f32x4*)(ys + 4); float* yd = YR + (size_t)rowf * 256 + ch; *(f32x4*)yd = y0; *(f32x4*)(yd + 4) = y1; }
    __syncthreads();
    if (producer) RW_STAGE(0)
    __syncthreads();
    for (int ci = 0; ci < NCH; ++ci) {
        if (producer) { if (ci + 1 < NCH) RW_STAGE(ci + 1)
            if (ci > 0) RW_FLUSH(ci - 1) }
        else {
            LAS float* Rs = base + (ci & 1) * BSZ; LAS float* Ws = Rs + ASZ; LAS float* KDs = Ws + ASZ; LAS float* KKs = KDs + ASZ; LAS float* Bs = KKs + ASZ; LAS float* Vs = Bs + ASZ;
            const int row0 = chain_row(b, dir, ci * CH), sgn = dir ? -1 : 1;
            const int ok = 8 * kj, ov = 2 * vg;
#define RW_LD(dst, arr, o) dst##a = *(const LAS f32x4*)(arr + (o) + ok); dst##b = *(const LAS f32x4*)(arr + (o) + ok + 4)
#define RW_LOADSET(X, o) RW_LD(kk##X, KKs, o); RW_LD(w##X, Ws, o); RW_LD(b##X, Bs, o); RW_LD(kd##X, KDs, o); RW_LD(r##X, Rs, o); v##X = *(const LAS f32x2*)(Vs + (o) + ov)
#define RW_STEP(T, C, N) { RW_LOADSET(N, ((T) + 1) * 64); \
                f32x4 p0 = S0a * kk##C##a + S0b * kk##C##b, p1 = S1a * kk##C##a + S1b * kk##C##b; \
                const float sa0 = row8_sum((p0[0] + p0[1]) + (p0[2] + p0[3])), sa1 = row8_sum((p1[0] + p1[1]) + (p1[2] + p1[3])); \
                S0a = S0a * w##C##a + (kd##C##a * v##C[0] - b##C##a * sa0); S0b = S0b * w##C##b + (kd##C##b * v##C[0] - b##C##b * sa0); \
                S1a = S1a * w##C##a + (kd##C##a * v##C[1] - b##C##a * sa1); S1b = S1b * w##C##b + (kd##C##b * v##C[1] - b##C##b * sa1); \
                p0 = S0a * r##C##a + S0b * r##C##b; p1 = S1a * r##C##a + S1b * r##C##b; \
                f32x2 y; y[0] = row8_sum((p0[0] + p0[1]) + (p0[2] + p0[3])); y[1] = row8_sum((p1[0] + p1[1]) + (p1[2] + p1[3])); \
                *(LAS f32x2*)(ybuf + (ci & 1) * ASZ + (T) * 64 + ov) = y; }
            f32x4 kkAa, kkAb, wAa, wAb, bAa, bAb, kdAa, kdAb, rAa, rAb, kkBa, kkBb, wBa, wBb, bBa, bBb, kdBa, kdBb, rBa, rBb; f32x2 vA, vB;
            RW_LOADSET(A, 0);
            for (int t = 0; t < CH; t += 2) { RW_STEP(t, A, B) RW_STEP(t + 1, B, A) }
#undef RW_STEP
#undef RW_LOADSET
#undef RW_LD
        }
        __syncthreads();
    }
    if (producer) RW_FLUSH(NCH - 1)
    __syncthreads();
#undef RW_FLUSH
#undef RW_STAGE
}

__device__ __forceinline__ float log_sigmoid_(float x) { return fminf(x, 0.f) - log1pf(__expf(-fabsf(x))); }
__device__ __forceinline__ void mlstm_chain(const Params& p, int l, int chain, LAS unsigned char* lds) {
    const int tid = opaque_tid(), wave = tid >> 6, lane = tid & 63, fr = lane & 15, fq = lane >> 4;
    const int b = chain >> 3, h = (chain >> 1) & 3, dir = chain & 1;
    constexpr int PT = 72;
    LAS bf16_t* Qs = (LAS bf16_t*)lds; LAS bf16_t* Ks = Qs + 64 * PT; LAS bf16_t* Kt = Ks + 64 * PT; LAS bf16_t* Vt = Kt + 64 * PT; LAS bf16_t* Ss = Vt + 64 * PT; LAS bf16_t* Cs = Ss + 64 * PT;
    LAS float* fb = (LAS float*)(lds + 6 * 64 * PT * 2);
    LAS float* ib = fb; LAS float* mxs = fb + 64; LAS float* wint = fb + 128; LAS float* emt = fb + 192; LAS float* gw = fb + 256; LAS float* nvec = fb + 320; LAS float* nq = fb + 384;
    LAS float* dsum = fb + 448;   LAS float* scal = fb + 576;
    const bf16_t* P2 = (const bf16_t*)(p.ws + WS_P2);
    bf16_t* YM = (bf16_t*)(p.ws + WS_YM) + (size_t)dir * M * 256;
    const float* cw = p.in[I_MCONV] + (size_t)l * 3 * 512;
    const float bi_ = p.in[I_MBI][l * 8 + dir * 4 + h], bf_ = p.in[I_MBF][l * 8 + dir * 4 + h];
    for (int i = tid; i < 64 * PT; i += NT) Cs[i] = 0;
    if (tid < 64) nvec[tid] = 0.f;
    if (tid == 0) { scal[0] = 0.f; scal[1] = 0.f; }
    f32x4 accC[2] = {{0.f, 0.f, 0.f, 0.f}, {0.f, 0.f, 0.f, 0.f}};
    const int tA = wave >> 1, tB0 = 2 * (wave & 1);
    for (int ci = 0; ci < 36; ++ci) {
        __syncthreads();
        { const int t = tid >> 3, c8 = (tid & 7) * 8; const int row = chain_row(b, dir, ci * 64 + t);
          const int pos = row < MC ? (row & 255) : ((row - MC) & 2047), len = row < MC ? 256 : 2048;
          const u32x4 z4 = {0u, 0u, 0u, 0u};
          const bf16_t* base = P2 + (size_t)row * P2W;
#pragma unroll
          for (int part = 0; part < 2; ++part) { const int col = 768 + part * 256 + h * 64 + c8; const int wc = part * 256 + h * 64 + c8;
              const u32x4 cur = *(const u32x4*)(base + col);
              const u32x4 prv = pos > 0 ? *(const u32x4*)(base - P2W + col) : z4;
              const u32x4 nxt = pos < len - 1 ? *(const u32x4*)(base + P2W + col) : z4;
              float a[8], bb[8], d[8], o[8]; unpack8(prv, a); unpack8(cur, bb); unpack8(nxt, d);
#pragma unroll
              for (int e = 0; e < 8; ++e) { const float x = a[e] * cw[wc + e] + bb[e] * cw[512 + wc + e] + d[e] * cw[1024 + wc + e]; const float s = x * sigmoidf_(x); o[e] = part ? s * 0.125f : s; }
              const u32x4 pk = pack8(o);
              if (part == 0) *(LAS u32x4*)(Qs + t * PT + c8) = pk;
              else { *(LAS u32x4*)(Ks + t * PT + c8) = pk;
#pragma unroll
                  for (int e = 0; e < 8; ++e) Kt[(c8 + e) * PT + t] = (bf16_t)f2bf(o[e]); } }
          const u32x4 vr = *(const u32x4*)(base + 1280 + h * 64 + c8);
          Vt[(c8 + 0) * PT + t] = (bf16_t)(vr.x & 0xffffu); Vt[(c8 + 1) * PT + t] = (bf16_t)(vr.x >> 16); Vt[(c8 + 2) * PT + t] = (bf16_t)(vr.y & 0xffffu); Vt[(c8 + 3) * PT + t] = (bf16_t)(vr.y >> 16);
          Vt[(c8 + 4) * PT + t] = (bf16_t)(vr.z & 0xffffu); Vt[(c8 + 5) * PT + t] = (bf16_t)(vr.z >> 16); Vt[(c8 + 6) * PT + t] = (bf16_t)(vr.w & 0xffffu); Vt[(c8 + 7) * PT + t] = (bf16_t)(vr.w >> 16); }
        if (wave == 0) { const int row = chain_row(b, dir, ci * 64 + lane); const bf16_t* gp = P2 + (size_t)row * P2W + 1792;
            const float ig = bf2f(gp[dir * 4 + h]) + bi_, fg = log_sigmoid_(bf2f(gp[8 + dir * 4 + h]) + bf_);
            float bc = fg;
#pragma unroll
            for (int o = 1; o < 64; o <<= 1) { const float u = __shfl_up(bc, o); if (lane >= o) bc += u; }
            const float ibv = ig - bc; float pm = ibv;
#pragma unroll
            for (int o = 1; o < 64; o <<= 1) { const float u = __shfl_up(pm, o); if (lane >= o) pm = fmaxf(pm, u); }
            const float m = scal[0]; const float mx = fmaxf(m, pm); const float mx63 = __shfl(mx, 63), b63 = __shfl(bc, 63);
            ib[lane] = ibv; mxs[lane] = mx; wint[lane] = __expf(m - mx); emt[lane] = __expf(-(bc + mx)); gw[lane] = __expf(ibv - mx63);
            LDS_WAIT();
            if (lane == 0) { scal[1] = __expf(m - mx63); scal[0] = b63 + mx63; } }
        __syncthreads();
        {
#pragma unroll
            for (int ct = 0; ct < 2; ++ct) { const int st = tB0 + ct; f32x4 acc = {0.f, 0.f, 0.f, 0.f};
#pragma unroll
                for (int kk = 0; kk < 2; ++kk) { const bf16x8 a = *(const LAS bf16x8*)(Qs + (tA * 16 + fr) * PT + kk * 32 + fq * 8); const bf16x8 bq = *(const LAS bf16x8*)(Ks + (st * 16 + fr) * PT + kk * 32 + fq * 8);
                    acc = __builtin_amdgcn_mfma_f32_16x16x32_bf16(a, bq, acc, 0, 0, 0); }
                const int s = st * 16 + fr; const float ibs = ib[s];
                float rs[4];
#pragma unroll
                for (int j = 0; j < 4; ++j) { const int t = tA * 16 + fq * 4 + j; const float wv = s <= t ? __expf(ibs - mxs[t]) : 0.f; const float sv = acc[j] * wv; rs[j] = sv; Ss[t * PT + s] = (bf16_t)f2bf(sv); }
#pragma unroll
                for (int j = 0; j < 4; ++j) { float r = rs[j]; r = row16_sum(r); rs[j] = r; }
                if (fr == 0) {
#pragma unroll
                    for (int j = 0; j < 4; ++j) { const int t = tA * 16 + fq * 4 + j; if (ct == 0) dsum[(wave & 1) * 64 + t] = rs[j]; else dsum[(wave & 1) * 64 + t] += rs[j]; } }
                LDS_WAIT();
            }
            { const int t = tid >> 3, k8 = (tid & 7) * 8; float f[8]; unpack8(*(const LAS u32x4*)(Qs + t * PT + k8), f); float s = 0.f;
#pragma unroll
              for (int e = 0; e < 8; ++e) s += f[e] * nvec[k8 + e];
              s = row8_sum(s);
              if ((tid & 7) == 0) nq[t] = s; }
        }
        __syncthreads();
        {
            const int row0 = chain_row(b, dir, ci * 64), sgn = dir ? -1 : 1;
#pragma unroll
            for (int ct = 0; ct < 2; ++ct) { const int vt = tB0 + ct; f32x4 a1 = {0.f, 0.f, 0.f, 0.f}, a2 = {0.f, 0.f, 0.f, 0.f};
#pragma unroll
                for (int kk = 0; kk < 2; ++kk) { const bf16x8 sa = *(const LAS bf16x8*)(Ss + (tA * 16 + fr) * PT + kk * 32 + fq * 8); const bf16x8 vb = *(const LAS bf16x8*)(Vt + (vt * 16 + fr) * PT + kk * 32 + fq * 8);
                    a1 = __builtin_amdgcn_mfma_f32_16x16x32_bf16(sa, vb, a1, 0, 0, 0);
                    const bf16x8 qa = *(const LAS bf16x8*)(Qs + (tA * 16 + fr) * PT + kk * 32 + fq * 8); const bf16x8 cb = *(const LAS bf16x8*)(Cs + (vt * 16 + fr) * PT + kk * 32 + fq * 8);
                    a2 = __builtin_amdgcn_mfma_f32_16x16x32_bf16(qa, cb, a2, 0, 0, 0); }
#pragma unroll
                for (int j = 0; j < 4; ++j) { const int t = tA * 16 + fq * 4 + j; const float wi = wint[t];
                    const float den = dsum[t] + dsum[64 + t] + wi * nq[t]; const float hv = (a1[j] + wi * a2[j]) / fmaxf(fabsf(den), emt[t]);
                    YM[(size_t)(row0 + sgn * t) * 256 + h * 64 + vt * 16 + fr] = (bf16_t)f2bf(hv); } }
        }
        {
            const float dec = scal[1];
#pragma unroll
            for (int ct = 0; ct < 2; ++ct) { const int kt = tB0 + ct; f32x4 acc = accC[ct] * dec;
#pragma unroll
                for (int kk = 0; kk < 2; ++kk) { float f[8]; unpack8(*(const LAS u32x4*)(Vt + (tA * 16 + fr) * PT + kk * 32 + fq * 8), f);
                    const f32x4 g0 = *(const LAS f32x4*)(gw + kk * 32 + fq * 8), g1 = *(const LAS f32x4*)(gw + kk * 32 + fq * 8 + 4);
                    f[0] *= g0[0]; f[1] *= g0[1]; f[2] *= g0[2]; f[3] *= g0[3]; f[4] *= g1[0]; f[5] *= g1[1]; f[6] *= g1[2]; f[7] *= g1[3];
                    const u32x4 pa = pack8(f); const bf16x8 a = __builtin_bit_cast(bf16x8, pa);
                    const bf16x8 kb = *(const LAS bf16x8*)(Kt + (kt * 16 + fr) * PT + kk * 32 + fq * 8);
                    acc = __builtin_amdgcn_mfma_f32_16x16x32_bf16(a, kb, acc, 0, 0, 0); }
                accC[ct] = acc; }
        }
        __syncthreads();
        {
            const float dec = scal[1];
            if (tid < 64) { float s = 0.f;
                for (int sI = 0; sI < 64; ++sI) s += gw[sI] * bf2f(Ks[sI * PT + tid]);
                nvec[tid] = dec * nvec[tid] + s; }
#pragma unroll
            for (int ct = 0; ct < 2; ++ct) { const int kt = tB0 + ct;
#pragma unroll
                for (int j = 0; j < 4; ++j) Cs[(tA * 16 + fq * 4 + j) * PT + kt * 16 + fr] = (bf16_t)f2bf(accC[ct][j]); }
        }
    }
    __syncthreads();
}

__device__ __forceinline__ void attn_unit(const Params& p, int l, int u, LAS unsigned char* lds) {
    const int tid = opaque_tid(), wave = tid >> 6, lane = tid & 63, fr = lane & 15, fq = lane >> 4;
    constexpr int PT = 72;
    LAS bf16_t* Ks = (LAS bf16_t*)lds; LAS bf16_t* Vt = Ks + 64 * PT;
    const bf16_t* P2 = (const bf16_t*)(p.ws + WS_P2); bf16_t* Y = (bf16_t*)(p.ws + WS_P1);
    const float* ROPE = (const float*)(p.ws + WS_ROPE);
    int b, kvh, gp, qb, qrow0; bool lat;
    if (u < 1024) { lat = true; gp = u & 1; qb = (u >> 1) & 15; kvh = (u >> 5) & 1; b = u >> 6; qrow0 = MC + b * SEQ + qb * 128; }
    else { const int w = u - 1024; lat = false; gp = w & 1; qb = (w >> 1) & 1; kvh = (w >> 2) & 1; b = w >> 3; qrow0 = b * TC + qb * 128; }
    const int g = gp * 2 + (wave >> 2), head = kvh * 4 + g, qi0 = (wave & 3) * 32;
    constexpr float LOG2E = 1.4426950408889634f;
    bf16x8 Qf[2][2];
#pragma unroll
    for (int mt = 0; mt < 2; ++mt) { const int qi = qi0 + mt * 16 + fr; const bf16_t* qp = P2 + (size_t)(qrow0 + qi) * P2W + head * 64 + fq * 8;
        float a[8], c[8]; unpack8(*(const u32x4*)qp, a); unpack8(*(const u32x4*)(qp + 32), c);
        if (lat) { const float* rp = ROPE + ((size_t)(qb * 128 + qi) * 32 + fq * 8) * 2;
#pragma unroll
            for (int e = 0; e < 8; ++e) { const float cs = rp[2 * e], sn = rp[2 * e + 1]; const float u1 = a[e], u2 = c[e]; a[e] = u1 * cs - u2 * sn; c[e] = u1 * sn + u2 * cs; } }
#pragma unroll
        for (int e = 0; e < 8; ++e) { a[e] *= 0.125f * LOG2E; c[e] *= 0.125f * LOG2E; }
        const u32x4 pa = pack8(a), pc = pack8(c); Qf[mt][0] = __builtin_bit_cast(bf16x8, pa); Qf[mt][1] = __builtin_bit_cast(bf16x8, pc); }
    const float sink = p.in[I_SINK][l * 8 + head] * LOG2E;
    float mrun[2] = {sink, sink}, lrun[2] = {fq == 0 ? 1.f : 0.f, fq == 0 ? 1.f : 0.f};
    f32x4 O[2][4];
#pragma unroll
    for (int mt = 0; mt < 2; ++mt)
#pragma unroll
        for (int dt = 0; dt < 4; ++dt) O[mt][dt] = (f32x4){0.f, 0.f, 0.f, 0.f};
    const int bt_lo = lat ? (qb == 0 ? 2 : 0) : 0, nband = lat ? ((qb == 15 ? 4 : 6) - bt_lo) : 0, ntiles = 4 + nband;
    const int skey = tid >> 3, sg = tid & 7;
    u32x2 kl, kh; u32x4 vr;
#define ATT_TILE_ROW(i) ((i) < 4 ? b * TC + (i) * 64 : MC + b * SEQ + qb * 128 - 128 + ((i) - 4 + bt_lo) * 64)
    { const int krow0 = ATT_TILE_ROW(0); const bf16_t* kp = P2 + (size_t)(krow0 + skey) * P2W + 512 + kvh * 64;
      kl = *(const u32x2*)(kp + sg * 4); kh = *(const u32x2*)(kp + 32 + sg * 4); vr = *(const u32x4*)(kp + 128 + sg * 8); }
    for (int i = 0; i < ntiles; ++i) {
        const bool band = i >= 4; const int kpos0 = band ? qb * 128 - 128 + (i - 4 + bt_lo) * 64 : 0;
        __syncthreads();
        { u32x2 lo = kl, hi = kh;
          if (band) { const float* rp = ROPE + ((size_t)(kpos0 + skey) * 32 + sg * 4) * 2; const f32x4 r0 = *(const f32x4*)rp, r1 = *(const f32x4*)(rp + 4);
              const float a0 = bflo(lo.x), a1 = bfhi(lo.x), a2 = bflo(lo.y), a3 = bfhi(lo.y), c0 = bflo(hi.x), c1 = bfhi(hi.x), c2 = bflo(hi.y), c3 = bfhi(hi.y);
              lo.x = pk2(a0 * r0[0] - c0 * r0[1], a1 * r0[2] - c1 * r0[3]); lo.y = pk2(a2 * r1[0] - c2 * r1[1], a3 * r1[2] - c3 * r1[3]);
              hi.x = pk2(a0 * r0[1] + c0 * r0[0], a1 * r0[3] + c1 * r0[2]); hi.y = pk2(a2 * r1[1] + c2 * r1[0], a3 * r1[3] + c3 * r1[2]); }
          *(LAS u32x2*)(Ks + skey * PT + sg * 4) = lo; *(LAS u32x2*)(Ks + skey * PT + 32 + sg * 4) = hi;
          const int d0 = sg * 8;
          Vt[(d0 + 0) * PT + skey] = (bf16_t)(vr.x & 0xffffu); Vt[(d0 + 1) * PT + skey] = (bf16_t)(vr.x >> 16); Vt[(d0 + 2) * PT + skey] = (bf16_t)(vr.y & 0xffffu); Vt[(d0 + 3) * PT + skey] = (bf16_t)(vr.y >> 16);
          Vt[(d0 + 4) * PT + skey] = (bf16_t)(vr.z & 0xffffu); Vt[(d0 + 5) * PT + skey] = (bf16_t)(vr.z >> 16); Vt[(d0 + 6) * PT + skey] = (bf16_t)(vr.w & 0xffffu); Vt[(d0 + 7) * PT + skey] = (bf16_t)(vr.w >> 16); }
        __syncthreads();
        if (i + 1 < ntiles) { const int krow0 = ATT_TILE_ROW(i + 1); const bf16_t* kp = P2 + (size_t)(krow0 + skey) * P2W + 512 + kvh * 64;
            kl = *(const u32x2*)(kp + sg * 4); kh = *(const u32x2*)(kp + 32 + sg * 4); vr = *(const u32x4*)(kp + 128 + sg * 8); }
        bool needmask = false;
        if (band) { const int qbase = qb * 128 + qi0; const int dmin = kpos0 - (qbase + 31), dmax = kpos0 + 63 - qbase;
            if (dmin > 128 || dmax < -128) continue;
            needmask = (dmax > 128 || dmin < -128); }
        f32x4 Sx[2][4];
#pragma unroll
        for (int nt = 0; nt < 4; ++nt) { const bf16x8 k0 = *(const LAS bf16x8*)(Ks + (nt * 16 + fr) * PT + fq * 8), k1 = *(const LAS bf16x8*)(Ks + (nt * 16 + fr) * PT + 32 + fq * 8);
#pragma unroll
            for (int mt = 0; mt < 2; ++mt) { f32x4 acc = {0.f, 0.f, 0.f, 0.f};
                acc = __builtin_amdgcn_mfma_f32_16x16x32_bf16(k0, Qf[mt][0], acc, 0, 0, 0); acc = __builtin_amdgcn_mfma_f32_16x16x32_bf16(k1, Qf[mt][1], acc, 0, 0, 0); Sx[mt][nt] = acc; } }
        bf16x8 Pf[2][2];
#pragma unroll
        for (int mt = 0; mt < 2; ++mt) {
            if (needmask) { const int qp = qb * 128 + qi0 + mt * 16 + fr;
#pragma unroll
                for (int nt = 0; nt < 4; ++nt)
#pragma unroll
                    for (int j = 0; j < 4; ++j) { const int dlt = kpos0 + nt * 16 + 4 * fq + j - qp; if (dlt > 128 || dlt < -128) Sx[mt][nt][j] = -1e30f; } }
            float mx = mrun[mt];
#pragma unroll
            for (int nt = 0; nt < 4; ++nt) mx = fmaxf(fmaxf(mx, fmaxf(Sx[mt][nt][0], Sx[mt][nt][1])), fmaxf(Sx[mt][nt][2], Sx[mt][nt][3]));
            mx = fmaxf(mx, __shfl_xor(mx, 16)); mx = fmaxf(mx, __shfl_xor(mx, 32));
            const float alpha = __builtin_amdgcn_exp2f(mrun[mt] - mx); mrun[mt] = mx; float ls = 0.f;
#pragma unroll
            for (int nt = 0; nt < 4; ++nt)
#pragma unroll
                for (int j = 0; j < 4; ++j) { const float e = __builtin_amdgcn_exp2f(Sx[mt][nt][j] - mx); Sx[mt][nt][j] = e; ls += e; }
            lrun[mt] = lrun[mt] * alpha + ls;
#pragma unroll
            for (int dt = 0; dt < 4; ++dt) O[mt][dt] = O[mt][dt] * alpha;
#pragma unroll
            for (int kk = 0; kk < 2; ++kk) { u32x4 pw; pw.x = pk2(Sx[mt][2 * kk][0], Sx[mt][2 * kk][1]); pw.y = pk2(Sx[mt][2 * kk][2], Sx[mt][2 * kk][3]);
                pw.z = pk2(Sx[mt][2 * kk + 1][0], Sx[mt][2 * kk + 1][1]); pw.w = pk2(Sx[mt][2 * kk + 1][2], Sx[mt][2 * kk + 1][3]); Pf[mt][kk] = __builtin_bit_cast(bf16x8, pw); }
        }
#pragma unroll
        for (int dt = 0; dt < 4; ++dt)
#pragma unroll
            for (int kk = 0; kk < 2; ++kk) { const u32x2 va = *(const LAS u32x2*)(Vt + (dt * 16 + fr) * PT + kk * 32 + 4 * fq), vb = *(const LAS u32x2*)(Vt + (dt * 16 + fr) * PT + kk * 32 + 16 + 4 * fq);
                const u32x4 vw = {va.x, va.y, vb.x, vb.y}; const bf16x8 vf = __builtin_bit_cast(bf16x8, vw);
#pragma unroll
                for (int mt = 0; mt < 2; ++mt) O[mt][dt] = __builtin_amdgcn_mfma_f32_16x16x32_bf16(vf, Pf[mt][kk], O[mt][dt], 0, 0, 0); }
    }
#undef ATT_TILE_ROW
#pragma unroll
    for (int mt = 0; mt < 2; ++mt) { float ls = lrun[mt]; ls += __shfl_xor(ls, 16); ls += __shfl_xor(ls, 32); const float il = 1.f / ls;
        bf16_t* yp = Y + (size_t)(qrow0 + qi0 + mt * 16 + fr) * D + 256 + head * 64 + 4 * fq;
#pragma unroll
        for (int dt = 0; dt < 4; ++dt) { const f32x4 o = O[mt][dt] * il; u32x2 w; w.x = pk2(o[0], o[1]); w.y = pk2(o[2], o[3]); *(u32x2*)(yp + dt * 16) = w; } }
    __syncthreads();
}

__device__ __forceinline__ void phase_post(const Params& p, int l, int row_lo, int bid, int G) {
    const int tid = opaque_tid(), wave = tid >> 6, lane = tid & 63, c = 4 * lane;
    const float* YR = (const float*)(p.ws + WS_H); const bf16_t* YM = (const bf16_t*)(p.ws + WS_YM); const bf16_t* RKV = (const bf16_t*)(p.ws + WS_RKV);
    const bf16_t* Gb = (const bf16_t*)(p.ws + WS_G); const bf16_t* P2 = (const bf16_t*)(p.ws + WS_P2); bf16_t* Y = (bf16_t*)(p.ws + WS_P1);
    const f32x4 lnw = *(const f32x4*)(p.in[I_RLNW] + l * 256 + c), lnb = *(const f32x4*)(p.in[I_RLNB] + l * 256 + c), rk_ = *(const f32x4*)(p.in[I_RRK] + l * 256 + c),
                ng = *(const f32x4*)(p.in[I_MNG] + l * 256 + c);
    for (int row0 = row_lo + bid * 8 + wave; row0 < M; row0 += G * 16) {
        int rows[2]; rows[0] = row0; rows[1] = row0 + G * 8 < M ? row0 + G * 8 : row0;
        f32x4 ya[2], yb[2]; u32x2 rw[2], kw[2], vw[2], gw_[2], h0[2], h1[2], ow[2];
#pragma unroll
        for (int i = 0; i < 2; ++i) { const size_t row = (size_t)rows[i];
            ya[i] = *(const f32x4*)(YR + row * 256 + c); yb[i] = *(const f32x4*)(YR + ((size_t)M + row) * 256 + c);
            rw[i] = *(const u32x2*)(RKV + row * 768 + c); kw[i] = *(const u32x2*)(RKV + row * 768 + 256 + c); vw[i] = *(const u32x2*)(RKV + row * 768 + 512 + c);
            gw_[i] = *(const u32x2*)(Gb + row * 256 + c); h0[i] = *(const u32x2*)(YM + row * 256 + c); h1[i] = *(const u32x2*)(YM + ((size_t)M + row) * 256 + c);
            ow[i] = *(const u32x2*)(P2 + row * P2W + 1536 + c); }
        u32x2 wr_[2], wm_[2];
#pragma unroll
        for (int i = 0; i < 2; ++i) {
            { f32x4 y = ya[i] + yb[i];
              float s = y[0] + y[1] + y[2] + y[3]; s = row16_sum(s); const float mu = s * (1.f / 64.f);
              y = y - mu; float q = y[0] * y[0] + y[1] * y[1] + y[2] * y[2] + y[3] * y[3]; q = row16_sum(q);
              const float rs = rsqrtf(q * (1.f / 64.f) + 64e-5f);
              const float r[4] = {bflo(rw[i].x), bfhi(rw[i].x), bflo(rw[i].y), bfhi(rw[i].y)}, k[4] = {bflo(kw[i].x), bfhi(kw[i].x), bflo(kw[i].y), bfhi(kw[i].y)},
                          v[4] = {bflo(vw[i].x), bfhi(vw[i].x), bflo(vw[i].y), bfhi(vw[i].y)}, g[4] = {bflo(gw_[i].x), bfhi(gw_[i].x), bflo(gw_[i].y), bfhi(gw_[i].y)};
              float bs = r[0] * k[0] * rk_[0] + r[1] * k[1] * rk_[1] + r[2] * k[2] * rk_[2] + r[3] * k[3] * rk_[3];
              bs = row16_sum(bs);
              float o[4];
#pragma unroll
              for (int e = 0; e < 4; ++e) o[e] = (y[e] * rs * lnw[e] + lnb[e] + bs * v[e]) * g[e];
              wr_[i].x = pk2(o[0], o[1]); wr_[i].y = pk2(o[2], o[3]); }
            { f32x4 y = {bflo(h0[i].x) + bflo(h1[i].x), bfhi(h0[i].x) + bfhi(h1[i].x), bflo(h0[i].y) + bflo(h1[i].y), bfhi(h0[i].y) + bfhi(h1[i].y)};
              float s = y[0] + y[1] + y[2] + y[3]; s = row16_sum(s); const float mu = s * (1.f / 64.f);
              y = y - mu; float q = y[0] * y[0] + y[1] * y[1] + y[2] * y[2] + y[3] * y[3]; q = row16_sum(q);
              const float rs = rsqrtf(q * (1.f / 64.f) + 1e-6f);
              const float og[4] = {bflo(ow[i].x), bfhi(ow[i].x), bflo(ow[i].y), bfhi(ow[i].y)};
              float o[4];
#pragma unroll
              for (int e = 0; e < 4; ++e) o[e] = sigmoidf_(og[e]) * (y[e] * rs * ng[e]);
              wm_[i].x = pk2(o[0], o[1]); wm_[i].y = pk2(o[2], o[3]); }
        }
#pragma unroll
        for (int i = 0; i < 2; ++i) { *(u32x2*)(Y + (size_t)rows[i] * D + c) = wr_[i]; *(u32x2*)(Y + (size_t)rows[i] * D + 768 + c) = wm_[i]; }
    }
}

__device__ __forceinline__ void weights_work(const Params& p, int l, LAS unsigned char* lds, int it_lo, int it_hi, bool extras, int bi, int nb) {
    if (bi >= 0 && bi < nb) {
        const int ncb = (extras && nb > 222) ? nb - 111 : nb;
        convert_weights(p, l, lds, it_lo, it_hi, bi, ncb);
        if (extras) { convert_lora(p, l, bi, nb); phase_cvec(p, l, lds, bi, nb); }
    }
}
#define XB_TMO      128
#define XB_XCNT(j)  (256  + 64 * (j))
#define XB_XSUB(j)  (1280 + 64 * (j))
#define XB_XGEN(j)  (2304 + 64 * (j))
#define XB_TOP      3328
#define XB_TOPGEN   3392
#define XCD_BAR_WORDS 3456
#define XB_SPIN_CAP (1u << 18)

__device__ __forceinline__ unsigned xb_ld(unsigned* p)              { return __hip_atomic_load(p, __ATOMIC_RELAXED, __HIP_MEMORY_SCOPE_AGENT); }
__device__ __forceinline__ unsigned xb_add(unsigned* p, unsigned v) { return __hip_atomic_fetch_add(p, v, __ATOMIC_RELAXED, __HIP_MEMORY_SCOPE_AGENT); }
__device__ __forceinline__ unsigned xb_xcc_id() { return (unsigned)__builtin_amdgcn_s_getreg((3 << 11) | 20) & 0xFu; }
#define XB_SPIN(cond, bar) do { unsigned _sp = 0; while (cond) { __builtin_amdgcn_s_sleep(1); \
    if ((++_sp & 255u) == 0u) { if (xb_ld(&(bar)[XB_TMO])) break; if (_sp > XB_SPIN_CAP) { atomicAdd(&(bar)[XB_TMO], 1u); break; } } } } while (0)

struct XcdBarrier {
    unsigned* bar; unsigned x;
    volatile LAS unsigned* st;
};

__device__ __forceinline__ XcdBarrier xcd_barrier_post(unsigned* bar, volatile LAS unsigned* st) {
    XcdBarrier b; b.bar = bar; b.x = xb_xcc_id(); b.st = st;
    if (threadIdx.x == 0) (void)xb_add(&bar[XB_XCNT(b.x)], 1u);
    return b;
}
__device__ __forceinline__ void xcd_barrier_complete(unsigned* bar, unsigned x, unsigned& nloc, unsigned& nx) {
    const unsigned G = gridDim.x * gridDim.y * gridDim.z;
    unsigned sum, cnt, mine, sp = 0u;
    for (;;) {
        sum = 0u; cnt = 0u; mine = 0u;
#pragma unroll
        for (unsigned j = 0; j < 16; ++j) { const unsigned c = xb_ld(&bar[XB_XCNT(j)]); sum += c; cnt += (c > 0u) ? 1u : 0u; mine = (j == x) ? c : mine; }
        if (sum == G) break;
        __builtin_amdgcn_s_sleep(1);
        if ((++sp & 255u) == 0u) { if (xb_ld(&bar[XB_TMO])) break; if (sp > XB_SPIN_CAP) { atomicAdd(&bar[XB_TMO], 1u); break; } }
    }
    nloc = mine > 0u ? mine : 1u; nx = cnt > 0u ? cnt : 1u;
}

__device__ __forceinline__ void xcd_barrier(const XcdBarrier& b) {
    asm volatile("s_waitcnt vmcnt(0)" ::: "memory");
    __syncthreads();
    if (threadIdx.x == 0) {
        unsigned* bar = b.bar;
        __builtin_amdgcn_s_waitcnt(0);
        unsigned nloc = b.st[0], nx = b.st[1];
        if (nloc == 0u) { xcd_barrier_complete(bar, b.x, nloc, nx); b.st[0] = nloc; b.st[1] = nx; }
        const unsigned old = xb_add(&bar[XB_XSUB(b.x)], 1u);
        const unsigned gen = old / nloc;
        if (old + 1u == (gen + 1u) * nloc) {
            __builtin_amdgcn_fence(__ATOMIC_RELEASE, "agent");
            asm volatile("s_waitcnt vmcnt(0)" ::: "memory");
            const unsigned og = xb_add(&bar[XB_TOP], 1u);
            const unsigned tg = og / nx;
            if (og + 1u == (tg + 1u) * nx) xb_add(&bar[XB_TOPGEN], 1u);
            else XB_SPIN(xb_ld(&bar[XB_TOPGEN]) == tg, bar);
            __builtin_amdgcn_fence(__ATOMIC_ACQUIRE, "agent");
            xb_add(&bar[XB_XGEN(b.x)], 1u);
            asm volatile("s_waitcnt vmcnt(0)" ::: "memory");
        } else {
            XB_SPIN(xb_ld(&bar[XB_XGEN(b.x)]) == gen, bar);
            __builtin_amdgcn_fence(__ATOMIC_ACQUIRE, "agent");
            asm volatile("s_waitcnt vmcnt(0)" ::: "memory");
        }
    }
    __syncthreads();
}

constexpr int N_PHASES = 2 + 8 * DEPTH;
__global__ void __launch_bounds__(NT, 2) fwd_megakernel(Params p) {
    extern __shared__ __attribute__((aligned(16))) unsigned char lds_raw[];
    LAS unsigned char* lds = (LAS unsigned char*)lds_raw;
    cg::grid_group grid = cg::this_grid();
    { volatile LAS unsigned* stz = (volatile LAS unsigned*)(lds + LDS_BYTES - 48); if (threadIdx.x < 4) stz[threadIdx.x] = 0u; }
    __syncthreads();
    XcdBarrier xbar = xcd_barrier_post((unsigned*)(p.ws + WS_BAR), (volatile LAS unsigned*)(lds + LDS_BYTES - 48));
#ifndef DUPM
#define DUPM 0
#endif
    for (int ph = p.ph_lo; ph < p.ph_hi; ++ph) {
      const int nrep = (DUPM && ph >= 1 && ph < N_PHASES - 1 && ((DUPM >> ((ph - 1) % 8)) & 1)) ? 2 : 1;
      for (int rep = 0; rep < nrep; ++rep) {
        int bid = blockIdx.x, G = gridDim.x; asm volatile("" : "+s"(bid), "+s"(G));
        bool skip_bar = false;
        float* Xc = (float*)(p.ws + WS_XC);
#ifndef PHM
#define PHM 0xffff
#endif
        if (ph == 0) { if (PHM & 1) phase_adaln(p, lds, bid, G); }
        else if (ph == N_PHASES - 1) { if (PHM & 2) phase_final(p, bid, G); }
        else {
            const int l = (ph - 1) / 8, s = (ph - 1) % 8; const bool last = (l == DEPTH - 1);
            const int row_lo = last ? MC : 0;
            const float* modl = (const float*)(p.ws + WS_MOD) + (size_t)l * 17 * 6144;
            int w_l = -1, w_lo = 0, w_hi = 0, w_bi = 0, w_nb = 0; bool w_ex = false;
            const bool pre = (G == 256);
            if (s == 0) { if (pre && l > 0) skip_bar = true;
                else { w_l = l; w_bi = bid; w_nb = G; w_lo = 0; w_hi = CW_ITOT; w_ex = true; } }
            else if (s == 1) { if (PHM & 16) { pg8::Gemm g{(const pg8::bf16_t*)(p.ws + WS_H), (const pg8::bf16_t*)(p.ws + WS_WIN), M, NINP, D}; pg8::StaticOrder S; S.init(M, NINP, G, bid);
                EpiIn E{(bf16_t*)(p.ws + WS_P1), (bf16_t*)(p.ws + WS_P2), (const float*)(p.ws + WS_RSQ1), (const float*)(p.ws + WS_CV1)}; pg8::gemm_phase<EpiIn, pg8::StaticOrder, true, true>(lds, g, S, E); }
                if (pre && l > 0) { w_l = l; w_lo = CW_I123; w_hi = CW_ITOT; w_ex = false; w_bi = bid - 192; w_nb = 64; } }
            else if (s == 2) { if (PHM & 32) phase_prep(p, l, lds, bid, G); }
            else if (s == 3) {
                const int natt = last ? 1024 : 1152;
                unsigned* qctr = (unsigned*)(p.ws + WS_CTR) + l * 64;
                LAS int* qslot = (LAS int*)(lds + LDS_BYTES - 64);
                for (int c = bid; c < 256; c += G) {
                    if (c < 128) { if (PHM & 64) rwkv_chain(p, l, c, lds); }
                    else { if (PHM & 128) mlstm_chain(p, l, c - 128, lds); } }
                for (;;) {
                    if (opaque_tid() == 0) *qslot = (int)__hip_atomic_fetch_add(qctr, 1u, __ATOMIC_RELAXED, __HIP_MEMORY_SCOPE_AGENT);
                    __syncthreads();
                    const int u = *qslot;
                    __syncthreads();
                    if (u >= natt) break;
                    if (PHM & 256) attn_unit(p, l, u, lds);
                }
            }
            else if (s == 4) { phase_post(p, l, row_lo, bid, G); }
            else if (s == 5) { if (PHM & 2048) { const int Mg = M - row_lo; pg8::Gemm g{(const pg8::bf16_t*)(p.ws + WS_P1) + (size_t)row_lo * D, (const pg8::bf16_t*)(p.ws + WS_WOUT), Mg, D, D}; pg8::StaticOrder S; S.init(Mg, D, G, bid);
                EpiRes E{Xc, p.out, modl, 2, row_lo, (bf16_t*)(p.ws + WS_H), (float*)(p.ws + WS_RSQ2), p.in[I_N2G] + l * D, modl, 4}; pg8::gemm_phase<EpiRes, pg8::StaticOrder, true, true>(lds, g, S, E); } }
            else if (s == 6) { if (PHM & 8192) { const int Mg = M - row_lo; pg8::Gemm g{(const pg8::bf16_t*)(p.ws + WS_H) + (size_t)row_lo * D, (const pg8::bf16_t*)(p.ws + WS_W1), Mg, DFF, D}; pg8::StaticOrder S; S.init(Mg, DFF, G, bid);
                EpiSq E{(bf16_t*)(p.ws + WS_P1) + (size_t)row_lo * DFF, (const float*)(p.ws + WS_RSQ2), (const float*)(p.ws + WS_CV2), row_lo}; pg8::gemm_phase<EpiSq, pg8::StaticOrder, true, true>(lds, g, S, E); } }
            else if (PHM & 16384) { const int Mg = M - row_lo; pg8::Gemm g{(const pg8::bf16_t*)(p.ws + WS_P1) + (size_t)row_lo * DFF, (const pg8::bf16_t*)(p.ws + WS_W2), Mg, D, DFF}; pg8::StaticOrder S; S.init(Mg, D, G, bid);
                EpiRes E{Xc, p.out, modl, 5, row_lo, (bf16_t*)(p.ws + WS_H), (float*)(p.ws + WS_RSQ1), p.in[I_N1G] + (last ? l : l + 1) * D, last ? modl : modl + 17 * 6144, 1}; pg8::gemm_phase<EpiRes, pg8::StaticOrder, true, true>(lds, g, S, E);
                if (pre && !last) { w_l = l + 1; w_lo = 0; w_hi = CW_I123; w_ex = true; w_bi = bid - 64; w_nb = 192; } }
            if (w_l >= 0) weights_work(p, w_l, lds, w_lo, w_hi, w_ex, w_bi, w_nb);
            if (s == 0 && l == 0) phase_boot(p, bid, G);
        }
        if ((ph + 1 < p.ph_hi || rep + 1 < nrep) && !skip_bar) { if (ph == 0) grid.sync(); else xcd_barrier(xbar); }
      }
    }
}

#ifndef MK_ONE_LAUNCH
#define MK_ONE_LAUNCH 1
#endif
extern "C" void kernel_launch(void* const* d_in, const int* in_sizes, int n_in, void* d_out, int out_size, void* d_ws, size_t ws_size, hipStream_t stream) {
    static int grid = 0;
    if (grid == 0) {
        if (n_in != 29 || out_size != ML * D || ws_size < WS_END) { fprintf(stderr, "kernel_launch: unexpected shapes: n_in %d out %d ws %zu (need %zu)\n", n_in, out_size, ws_size, (size_t)WS_END); grid = -1; return; }
        int dev = 0, cus = 0, per_cu = 0;
        hipGetDevice(&dev); hipDeviceGetAttribute(&cus, hipDeviceAttributeMultiprocessorCount, dev);
        if (hipFuncSetAttribute((const void*)fwd_megakernel, hipFuncAttributeMaxDynamicSharedMemorySize, LDS_BYTES) != hipSuccess) { fprintf(stderr, "kernel_launch: hipFuncSetAttribute failed\n"); grid = -1; return; }
        if (hipOccupancyMaxActiveBlocksPerMultiprocessor(&per_cu, (const void*)fwd_megakernel, NT, LDS_BYTES) != hipSuccess || per_cu < 1) { fprintf(stderr, "kernel_launch: occupancy query says %d\n", per_cu); per_cu = 1; }
        (void)hipGetLastError();
        grid = cus * per_cu;
        fprintf(stderr, "kernel_launch: grid %d (cus %d x %d)\n", grid, cus, per_cu);
    }
    if (grid < 0) return;
    Params p{};
    for (int i = 0; i < 29; ++i) p.in[i] = (const float*)d_in[i];
    p.out = (float*)d_out; p.ws = (unsigned char*)d_ws;
#if MK_ONE_LAUNCH
    p.ph_lo = 0; p.ph_hi = N_PHASES;
    (void)hipMemsetAsync((char*)d_ws + WS_CTR, 0, 4096 + 16384, stream);
    { void* args[] = {&p}; hipError_t e = hipLaunchCooperativeKernel((const void*)fwd_megakernel, dim3(grid), dim3(NT), args, LDS_BYTES, stream);
      if (e != hipSuccess) fprintf(stderr, "cooperative launch failed: %s (grid %d)\n", hipGetErrorString(e), grid); }
#else
    for (int ph = 0; ph < N_PHASES; ++ph) { p.ph_lo = ph; p.ph_hi = ph + 1; hipLaunchKernelGGL(fwd_megakernel, dim3(grid), dim3(NT), LDS_BYTES, stream, p); }
#endif
}
```

```cpp
#include <hip/hip_runtime.h>
#include <hip/hip_cooperative_groups.h>
#include <cstdio>
#include <cstdint>
namespace cg = cooperative_groups;

__device__ __forceinline__ int opaque_tid() { int t = threadIdx.x; asm volatile("" : "+v"(t)); return t; }
namespace pg8 {
#define PG8_LAS __attribute__((address_space(3)))
typedef unsigned short bf16_t;
typedef short bf16x8 __attribute__((ext_vector_type(8)));
typedef float f32x4 __attribute__((ext_vector_type(4)));
typedef unsigned u32x4 __attribute__((ext_vector_type(4)));
constexpr int BM = 256, BK = 64, HALF = 128, HTB = HALF * BK * 2  , STAGE_BYTES = 8 * HTB, NXCD = 8, WGM = 8;

__host__ __device__ __forceinline__ int lds_byte(int r, int c) { const int st = (r >> 4) * 2 + (c >> 5), rr = r & 15, cc = c & 31, ob = rr * 64 + cc * 2; return st * 1024 + (ob ^ (((ob >> 9) & 1) << 5)); }
__host__ __device__ __forceinline__ void stage_rc(int b, int& R, int& C) { const int st = b / 1024, sb = b % 1024, swz = sb ^ (((sb >> 9) & 1) << 5); R = (st >> 1) * 16 + swz / 64; C = (st & 1) * 32 + (swz % 64) / 2; }
__host__ __device__ __forceinline__ int perm32(int rho) { const int n = rho >> 4, i = rho & 15; return 8 * (i >> 2) + 4 * n + (i & 3); }

struct Unit { int pm, pn; };
struct Gemm { const bf16_t* A; const bf16_t* Bt; int M, N, K; };

struct StaticOrder {
    int nM, nN, nwg, G, c;
    __host__ __device__ void init(int M, int N, int G_, int c_) { nM = M / BM; nN = N / BM; nwg = nM * nN; G = G_; c = c_; }
    __host__ __device__ bool next(int i, Unit& u) const {
        const long L = (long)i * G + c; if (L >= nwg) return false;
        int wgid = (int)L; { const int q = nwg / NXCD, r = nwg % NXCD, xcd = wgid % NXCD, off = wgid / NXCD; wgid = (xcd < r ? xcd * (q + 1) : r * (q + 1) + (xcd - r) * q) + off; }
        const int nig = WGM * nN, gid = wgid / nig, fm = gid * WGM, gsz = (nM - fm) < WGM ? (nM - fm) : WGM;
        u.pm = fm + ((wgid % nig) % gsz); u.pn = (wgid % nig) / gsz; return true;
    }
    __device__ __forceinline__ void a_ready(const Unit&) const {}
    __device__ __forceinline__ void done(const Unit&) const {}
};

template <class Epi, class Sched, bool ALIGN_EPI = false, bool SP2 = false>
__device__ __forceinline__ void gemm_phase(PG8_LAS unsigned char* lds, const Gemm g, const Sched& S, const Epi& E) {
    const int tid = opaque_tid(), wid = __builtin_amdgcn_readfirstlane(tid >> 6), lane = tid & 63, wr = wid >> 2, wc = wid & 3, fr = lane & 15, fq = lane >> 4;
    const int K = g.K, nt = K / BK;
    unsigned voffA[2], voffB[2];
#pragma unroll
    for (int i = 0; i < 2; ++i) { int R, C; stage_rc(tid * 16 + i * 8192, R, C); const int Rb = Epi::PERM ? ((R & ~31) + perm32(R & 31)) : R;
        voffA[i] = (unsigned)(R * K + C) * 2u; voffB[i] = (unsigned)(Rb * K + C) * 2u; }
    const size_t kstep = (size_t)(BK * 2);
    const size_t hstep = (size_t)HALF * K * 2;
    const size_t tstep = 2 * hstep;
    const unsigned ldsw = (unsigned)wid * 1024u;
    const int aoff = lds_byte(wr * 64 + fr, fq * 8), boff = lds_byte(wc * 32 + fr, fq * 8);
#define PG8_SA(b, h) (((b) * 2 + (h)) * HTB)
#define PG8_SB(b, h) ((4 + (b) * 2 + (h)) * HTB)
#define PG8_STAGE(bufoff, gbase, voff) do { _Pragma("unroll") for (int _i = 0; _i < 2; ++_i) \
        __builtin_amdgcn_global_load_lds((const unsigned*)((const char*)(gbase) + (voff)[_i]), (PG8_LAS unsigned*)(lds + (bufoff) + ldsw + _i * 8192), 16, 0, 0); } while (0)
#define PG8_LDA(dst, b, h) do { _Pragma("unroll") for (int m = 0; m < 4; ++m) _Pragma("unroll") for (int k = 0; k < 2; ++k) dst[m][k] = *(const PG8_LAS bf16x8*)(lds + PG8_SA(b, h) + aoff + m * 2048 + k * 1024); } while (0)
#define PG8_LDB(dst, b, h) do { _Pragma("unroll") for (int n = 0; n < 2; ++n) _Pragma("unroll") for (int k = 0; k < 2; ++k) dst[n][k] = *(const PG8_LAS bf16x8*)(lds + PG8_SB(b, h) + boff + n * 2048 + k * 1024); } while (0)
#define PG8_MMA(ai, bj, At, Bt) do { __builtin_amdgcn_s_setprio(1); _Pragma("unroll") for (int m = 0; m < 4; ++m) _Pragma("unroll") for (int n = 0; n < 2; ++n) _Pragma("unroll") for (int k = 0; k < 2; ++k) \
        acc[ai][bj][m][n] = __builtin_amdgcn_mfma_f32_16x16x32_bf16(Bt[n][k], At[m][k], acc[ai][bj][m][n], 0, 0, 0); __builtin_amdgcn_s_setprio(0); } while (0)
#define PG8_WAIT_V(n) asm volatile("s_waitcnt vmcnt(" #n ")" ::: "memory")
#define PG8_WAIT_L(n) asm volatile("s_waitcnt lgkmcnt(" #n ")" ::: "memory")
#define PG8_BAR __builtin_amdgcn_s_barrier()
#define PG8_SCHED __builtin_amdgcn_sched_barrier(0)
    Unit cur, nxt; int ui = 0;
    if (!S.next(0, cur)) return;
    f32x4 acc[2][2][4][2];
#pragma unroll
    for (int a = 0; a < 2; ++a)
#pragma unroll
        for (int b = 0; b < 2; ++b)
#pragma unroll
            for (int m = 0; m < 4; ++m)
#pragma unroll
                for (int n = 0; n < 2; ++n) acc[a][b][m][n] = (f32x4){0.f, 0.f, 0.f, 0.f};
    bf16x8 At[4][2], B0[2][2], B1[2][2];
    const char* cA = (const char*)g.A + (size_t)cur.pm * tstep; const char* cB = (const char*)g.Bt + (size_t)cur.pn * tstep;
    S.a_ready(cur);
    if constexpr (SP2) {
        PG8_STAGE(PG8_SB(0, 0), cB, voffB); PG8_STAGE(PG8_SB(0, 1), cB + hstep, voffB); PG8_STAGE(PG8_SA(0, 0), cA, voffA); PG8_STAGE(PG8_SA(0, 1), cA + hstep, voffA);
        if (wr == 1) PG8_BAR;
        PG8_WAIT_V(2); PG8_BAR;
        PG8_STAGE(PG8_SB(1, 0), cB + kstep, voffB); PG8_STAGE(PG8_SA(1, 0), cA + kstep, voffA); PG8_STAGE(PG8_SB(1, 1), cB + hstep + kstep, voffB);
        PG8_WAIT_V(6); PG8_BAR;
    } else {
        PG8_STAGE(PG8_SB(0, 0), cB, voffB); PG8_STAGE(PG8_SA(0, 0), cA, voffA); PG8_STAGE(PG8_SB(0, 1), cB + hstep, voffB); PG8_STAGE(PG8_SA(0, 1), cA + hstep, voffA);
        if (wr == 1) PG8_BAR;
        PG8_WAIT_V(4); PG8_BAR;
        PG8_STAGE(PG8_SB(1, 0), cB + kstep, voffB); PG8_STAGE(PG8_SA(1, 0), cA + kstep, voffA); PG8_STAGE(PG8_SB(1, 1), cB + hstep + kstep, voffB);
        PG8_WAIT_V(6); PG8_BAR;
    }
    for (;;) {
        const bool has_next = S.next(ui + 1, nxt);
        const char* nA = has_next ? (const char*)g.A + (size_t)nxt.pm * tstep : cA; const char* nB = has_next ? (const char*)g.Bt + (size_t)nxt.pn * tstep : cB;
        for (int t = 0; t < nt; t += 2) {
            const bool last = (t == nt - 2);
            const char* a1 = cA + (size_t)(t + 1) * kstep;
            const char* a2 = last ? nA : cA + (size_t)(t + 2) * kstep; const char* b2 = last ? nB : cB + (size_t)(t + 2) * kstep;
            const char* a3 = a2 + kstep; const char* b3 = b2 + kstep;
            if (last && has_next) S.a_ready(nxt);
            if constexpr (SP2) {
            PG8_LDB(B0, 0, 0); PG8_LDB(B1, 0, 1); PG8_SCHED; PG8_LDA(At, 0, 0); PG8_STAGE(PG8_SA(1, 1), a1 + hstep, voffA);
            PG8_WAIT_V(8); PG8_WAIT_L(0); PG8_BAR; PG8_MMA(0, 0, At, B0); PG8_MMA(0, 1, At, B1); PG8_BAR; PG8_SCHED;
            PG8_LDA(At, 0, 1); PG8_STAGE(PG8_SB(0, 0), b2, voffB); PG8_STAGE(PG8_SB(0, 1), b2 + hstep, voffB); PG8_STAGE(PG8_SA(0, 0), a2, voffA);
            PG8_WAIT_V(8); PG8_WAIT_L(0); PG8_BAR; PG8_MMA(1, 0, At, B0); PG8_MMA(1, 1, At, B1); PG8_BAR; PG8_SCHED;
            PG8_LDB(B0, 1, 0); PG8_LDB(B1, 1, 1); PG8_SCHED; PG8_LDA(At, 1, 0); PG8_STAGE(PG8_SA(0, 1), a2 + hstep, voffA);
            PG8_WAIT_V(8); PG8_WAIT_L(0); PG8_BAR; PG8_MMA(0, 0, At, B0); PG8_MMA(0, 1, At, B1); PG8_BAR; PG8_SCHED;
            PG8_LDA(At, 1, 1); PG8_STAGE(PG8_SB(1, 0), b3, voffB); PG8_STAGE(PG8_SB(1, 1), b3 + hstep, voffB); PG8_STAGE(PG8_SA(1, 0), a3, voffA);
            PG8_WAIT_V(8); PG8_WAIT_L(0); PG8_BAR; PG8_MMA(1, 0, At, B0); PG8_MMA(1, 1, At, B1); PG8_BAR; PG8_SCHED;
            } else {
            PG8_LDB(B0, 0, 0); PG8_SCHED; PG8_LDA(At, 0, 0); PG8_STAGE(PG8_SA(1, 1), a1 + hstep, voffA);
            PG8_WAIT_L(8); PG8_BAR; PG8_WAIT_L(0); PG8_MMA(0, 0, At, B0); PG8_BAR; PG8_SCHED;
            PG8_LDB(B1, 0, 1); PG8_STAGE(PG8_SB(0, 0), b2, voffB);
            PG8_BAR; PG8_WAIT_L(0); PG8_MMA(0, 1, At, B1); PG8_BAR;
            PG8_LDA(At, 0, 1); PG8_STAGE(PG8_SA(0, 0), a2, voffA);
            PG8_BAR; PG8_WAIT_L(0); PG8_MMA(1, 0, At, B0); PG8_BAR; PG8_SCHED;
            PG8_STAGE(PG8_SB(0, 1), b2 + hstep, voffB);
            PG8_WAIT_V(6); PG8_BAR; PG8_MMA(1, 1, At, B1); PG8_BAR;
            PG8_LDB(B0, 1, 0); PG8_SCHED; PG8_LDA(At, 1, 0); PG8_STAGE(PG8_SA(0, 1), a2 + hstep, voffA);
            PG8_WAIT_L(8); PG8_BAR; PG8_WAIT_L(0); PG8_MMA(0, 0, At, B0); PG8_BAR; PG8_SCHED;
            PG8_LDB(B1, 1, 1); PG8_STAGE(PG8_SB(1, 0), b3, voffB);
            PG8_BAR; PG8_WAIT_L(0); PG8_MMA(0, 1, At, B1); PG8_BAR;
            PG8_LDA(At, 1, 1); PG8_STAGE(PG8_SA(1, 0), a3, voffA);
            PG8_BAR; PG8_WAIT_L(0); PG8_MMA(1, 0, At, B0); PG8_BAR; PG8_SCHED;
            PG8_STAGE(PG8_SB(1, 1), b3 + hstep, voffB);
            PG8_WAIT_V(6); PG8_BAR; PG8_MMA(1, 1, At, B1); PG8_BAR;
            }
        }
        if constexpr (ALIGN_EPI) { if (wr == 0) PG8_BAR; }
        if constexpr (!Epi::AFTER_DRAIN) { E(acc, cur, wr, wc, fr, fq); S.done(cur); }
        if (!has_next) break;
#pragma unroll
        for (int a = 0; a < 2; ++a)
#pragma unroll
            for (int b = 0; b < 2; ++b)
#pragma unroll
                for (int m = 0; m < 4; ++m)
#pragma unroll
                    for (int n = 0; n < 2; ++n) acc[a][b][m][n] = (f32x4){0.f, 0.f, 0.f, 0.f};
        cur = nxt; cA = nA; cB = nB; ++ui;
        if constexpr (ALIGN_EPI) { if (wr == 1) PG8_BAR; }
    }
    PG8_WAIT_V(0);
    if constexpr (!ALIGN_EPI) { if (wr == 0) PG8_BAR; }
    PG8_BAR;
    if constexpr (Epi::AFTER_DRAIN) { E.fused(acc, cur, wr, wc, fr, fq, lds, wid, lane); S.done(cur); }
#undef PG8_SA
#undef PG8_SB
#undef PG8_STAGE
#undef PG8_LDA
#undef PG8_LDB
#undef PG8_MMA
#undef PG8_WAIT_V
#undef PG8_WAIT_L
#undef PG8_BAR
#undef PG8_SCHED
}
}


#define LAS __attribute__((address_space(3)))
typedef unsigned short bf16_t;
typedef short bf16x8 __attribute__((ext_vector_type(8)));
typedef float f32x4 __attribute__((ext_vector_type(4)));
typedef unsigned u32x4 __attribute__((ext_vector_type(4)));
typedef unsigned u32x2 __attribute__((ext_vector_type(2)));

constexpr int D = 1024, NB = 16, SEQ = 2048, TC = 256, DEPTH = 4;
constexpr int MC = NB * TC, ML = NB * SEQ, M = MC + ML;
constexpr int NIN = 2960, NINP = 3072, P1W = 1152, P2W = 1808, DFF = 4096;
constexpr int NT = 512;
constexpr int LDS_BYTES = 132096;

constexpr size_t WS_MOD = 0;
constexpr size_t WS_CTR = WS_MOD + 1835008;
constexpr size_t WS_BAR = WS_CTR + 4096;
constexpr size_t WS_ROPE = WS_MOD + 2097152;
constexpr size_t WS_XC = WS_ROPE + 524288;
constexpr size_t WS_WIN = WS_XC + (size_t)MC * D * 4;
constexpr size_t WS_WOUT = WS_WIN + (size_t)NINP * D * 2;
constexpr size_t WS_W1 = WS_WOUT + (size_t)D * D * 2;
constexpr size_t WS_W2 = WS_W1 + (size_t)DFF * D * 2;
constexpr size_t WS_H = WS_W2 + (size_t)DFF * D * 2;
constexpr size_t WS_P1 = WS_H + (size_t)M * D * 2;
constexpr size_t WS_P2 = WS_P1 + (size_t)M * P1W * 2;
constexpr size_t WS_RKV = WS_P2 + (size_t)M * P2W * 2;
constexpr size_t WS_WD = WS_RKV + (size_t)M * 768 * 2;
constexpr size_t WS_AD = WS_WD + (size_t)2 * M * 256 * 2;
constexpr size_t WS_G = WS_AD + (size_t)2 * M * 256 * 2;
constexpr size_t WS_YM = WS_G + (size_t)M * 256 * 2;
constexpr size_t WS_LW = WS_YM + (size_t)2 * M * 256 * 2;
constexpr size_t WS_RSQ1 = WS_LW + 262144;
constexpr size_t WS_RSQ2 = WS_RSQ1 + (size_t)M * 64;
constexpr size_t WS_CV1 = WS_RSQ2 + (size_t)M * 64;
constexpr size_t WS_CV2 = WS_CV1 + (size_t)17 * NINP * 4;
constexpr size_t WS_END = WS_CV2 + (size_t)17 * DFF * 4;
static_assert(WS_END <= 536870912ull, "workspace map exceeds 512 MiB");
static_assert(WS_P1 + (size_t)M * DFF * 2 <= WS_AD, "hidden overlay must end inside the dead mixer buffers");

struct Params { const float* in[29]; float* out; unsigned char* ws; int ph_lo, ph_hi; };
enum { I_X = 0, I_C, I_CTX, I_CCTX, I_ADAW, I_ADAB, I_N1G, I_N2G, I_WIN, I_WOUT, I_RCONV, I_RW0, I_RWUP, I_RA0, I_RAUP, I_RGUP, I_RKK, I_RKA, I_RRK, I_RLNW, I_RLNB,
       I_SINK, I_MCONV, I_MBI, I_MBF, I_MNG, I_W1, I_W2, I_FG };

__device__ __forceinline__ unsigned f2bf(float f) { unsigned u = __builtin_bit_cast(unsigned, f); return (u + 0x7fffu + ((u >> 16) & 1u)) >> 16; }
__device__ __forceinline__ float bf2f(unsigned b) { return __builtin_bit_cast(float, (b & 0xffffu) << 16); }
__device__ __forceinline__ float bflo(unsigned w) { return __builtin_bit_cast(float, w << 16); }
__device__ __forceinline__ float bfhi(unsigned w) { return __builtin_bit_cast(float, w & 0xffff0000u); }
__device__ __forceinline__ unsigned pk2(float lo, float hi) { unsigned r; asm("v_cvt_pk_bf16_f32 %0, %1, %2" : "=v"(r) : "v"(lo), "v"(hi)); return r; }
__device__ __forceinline__ float sigmoidf_(float x) { return __builtin_amdgcn_rcpf(1.f + __expf(-x)); }
__device__ __forceinline__ float row16_sum(float v);
__device__ __forceinline__ float wave_sum(float v) { v = row16_sum(v); v += __shfl_xor(v, 16); v += __shfl_xor(v, 32); return v; }
template <int CTRL> __device__ __forceinline__ float dpp_f(float v) { return __builtin_bit_cast(float, __builtin_amdgcn_update_dpp(0, __builtin_bit_cast(int, v), CTRL, 0xf, 0xf, true)); }
__device__ __forceinline__ float row16_sum(float v) { v += dpp_f<0xB1>(v); v += dpp_f<0x4E>(v); v += dpp_f<0x124>(v); v += dpp_f<0x128>(v); return v; }
__device__ __forceinline__ float row8_sum(float v) { v += dpp_f<0xB1>(v); v += dpp_f<0x4E>(v); v += dpp_f<0x141>(v); return v; }
typedef float f32x2 __attribute__((ext_vector_type(2)));
#define LDS_WAIT() asm volatile("s_waitcnt lgkmcnt(0)" ::: "memory")
__device__ __forceinline__ void unpack8(const u32x4 w, float (&f)[8]) {
    f[0] = bflo(w.x); f[1] = bfhi(w.x); f[2] = bflo(w.y); f[3] = bfhi(w.y); f[4] = bflo(w.z); f[5] = bfhi(w.z); f[6] = bflo(w.w); f[7] = bfhi(w.w);
}
__device__ __forceinline__ u32x4 pack8(const float (&f)[8]) { u32x4 o; o.x = pk2(f[0], f[1]); o.y = pk2(f[2], f[3]); o.z = pk2(f[4], f[5]); o.w = pk2(f[6], f[7]); return o; }
__device__ __forceinline__ float h2f(unsigned bits) { return (float)__builtin_bit_cast(_Float16, (unsigned short)bits); }
__device__ __forceinline__ unsigned f2h(float f) { return (unsigned)__builtin_bit_cast(unsigned short, (_Float16)f); }

__device__ __forceinline__ int chain_row(int b, int dir, int n) {
    if (n < TC) { const int t = dir ? (TC - 1 - n) : n; return b * TC + t; }
    int s = n - TC; s = dir ? (SEQ - 1 - s) : s; return MC + b * SEQ + s;
}

__device__ __forceinline__ void epi_row_scales(const float* rsq, int rowbase, int fq, float (&rs)[2][4]) {
    f32x4 q[2][4];
#pragma unroll
    for (int ai = 0; ai < 2; ++ai)
#pragma unroll
        for (int m = 0; m < 4; ++m) q[ai][m] = *(const f32x4*)(rsq + (size_t)(rowbase + ai * 128 + m * 16) * 16 + 4 * fq);
#pragma unroll
    for (int ai = 0; ai < 2; ++ai)
#pragma unroll
        for (int m = 0; m < 4; ++m) { float t = (q[ai][m][0] + q[ai][m][1]) + (q[ai][m][2] + q[ai][m][3]); t += __shfl_xor(t, 16); t += __shfl_xor(t, 32); rs[ai][m] = rsqrtf(t * (1.f / D) + 1e-6f); }
}
struct EpiIn {
    static constexpr bool PERM = true, AFTER_DRAIN = false;
    bf16_t* P1; bf16_t* P2; const float* rsq; const float* cv;
    __device__ __forceinline__ void operator()(const f32x4 (&acc)[2][2][4][2], const pg8::Unit& u, int wr, int wc, int fr, int fq) const {
        const int row0 = u.pm * 256 + wr * 64 + fr, col0 = u.pn * 256 + wc * 32 + 8 * fq;
        const int rowu = u.pm * 256; const float* cvp = cv + (size_t)(rowu < MC ? 16 : ((rowu - MC) >> 11)) * NINP + col0;
        f32x4 c4[2][2];
#pragma unroll
        for (int bj = 0; bj < 2; ++bj)
#pragma unroll
            for (int n = 0; n < 2; ++n) c4[bj][n] = *(const f32x4*)(cvp + bj * 128 + n * 4);
        float rsv[2][4]; epi_row_scales(rsq, row0, fq, rsv);
#pragma unroll
        for (int ai = 0; ai < 2; ++ai)
#pragma unroll
            for (int m = 0; m < 4; ++m) { const int rowi = row0 + ai * 128 + m * 16; const size_t row = (size_t)rowi;
                const float rs = rsv[ai][m];
#pragma unroll
                for (int bj = 0; bj < 2; ++bj) { const int col = col0 + bj * 128; const f32x4 v0 = acc[ai][bj][m][0] * rs + c4[bj][0], v1 = acc[ai][bj][m][1] * rs + c4[bj][1];
                    u32x4 o; o.x = pk2(v0[0], v0[1]); o.y = pk2(v0[2], v0[3]); o.z = pk2(v1[0], v1[1]); o.w = pk2(v1[2], v1[3]);
                    if (col < P1W) *(u32x4*)(P1 + row * P1W + col) = o;
                    else if (col < NIN) *(u32x4*)(P2 + row * P2W + (col - P1W)) = o; } }
    }
};
struct EpiRes {
    static constexpr bool PERM = true, AFTER_DRAIN = false;
    float* Xc; float* Xl; const float* modl; int gate_idx; int row_off;
    bf16_t* Hn; float* rsq; const float* gn; const float* modn; int sc_idx;
    __device__ __forceinline__ void operator()(const f32x4 (&acc)[2][2][4][2], const pg8::Unit& u, int wr, int wc, int fr, int fq) const {
        const int row0 = row_off + u.pm * 256 + wr * 64 + fr, col0 = u.pn * 256 + wc * 32 + 8 * fq;
        const int rowu = row_off + u.pm * 256, bi = rowu < MC ? 16 : ((rowu - MC) >> 11);
        const float* gp = modl + (size_t)bi * 6144 + gate_idx * 1024 + col0;
        f32x4 g4[2][2], s4[2][2];
#pragma unroll
        for (int bj = 0; bj < 2; ++bj)
#pragma unroll
            for (int n = 0; n < 2; ++n) { g4[bj][n] = *(const f32x4*)(gp + bj * 128 + n * 4);
                s4[bj][n] = *(const f32x4*)(gn + col0 + bj * 128 + n * 4) * (*(const f32x4*)(modn + (size_t)bi * 6144 + sc_idx * 1024 + col0 + bj * 128 + n * 4) + 1.f); }
        float* xb = (rowu < MC ? Xc + (size_t)row0 * D : Xl + (size_t)(row0 - MC) * D) + col0;
#pragma unroll
        for (int am = 0; am < 4; ++am) { const int ai = am >> 1, mb = (am & 1) * 2;
            f32x4 xv[2][2][2];
#pragma unroll
            for (int m = 0; m < 2; ++m)
#pragma unroll
                for (int bj = 0; bj < 2; ++bj)
#pragma unroll
                    for (int n = 0; n < 2; ++n) xv[m][bj][n] = *(const f32x4*)(xb + (size_t)(ai * 128 + (mb + m) * 16) * D + bj * 128 + n * 4);
            asm volatile("s_waitcnt vmcnt(0)" ::: "memory");
#pragma unroll
            for (int m = 0; m < 2; ++m) { const int row = row0 + ai * 128 + (mb + m) * 16; float* xp = xb + (size_t)(ai * 128 + (mb + m) * 16) * D;
                float ss = 0.f;
#pragma unroll
                for (int bj = 0; bj < 2; ++bj) { const int co = bj * 128;
                    const f32x4 x0 = xv[m][bj][0] + g4[bj][0] * acc[ai][bj][mb + m][0], x1 = xv[m][bj][1] + g4[bj][1] * acc[ai][bj][mb + m][1];
                    *(f32x4*)(xp + co) = x0; *(f32x4*)(xp + co + 4) = x1;
                    const f32x4 h0 = x0 * s4[bj][0], h1 = x1 * s4[bj][1]; u32x4 o; o.x = pk2(h0[0], h0[1]); o.y = pk2(h0[2], h0[3]); o.z = pk2(h1[0], h1[1]); o.w = pk2(h1[2], h1[3]);
                    *(u32x4*)(Hn + (size_t)row * D + col0 + co) = o;
                    ss += ((x0[0] * x0[0] + x0[1] * x0[1]) + (x0[2] * x0[2] + x0[3] * x0[3])) + ((x1[0] * x1[0] + x1[1] * x1[1]) + (x1[2] * x1[2] + x1[3] * x1[3])); }
                ss += __shfl_xor(ss, 16); ss += __shfl_xor(ss, 32); if (fq == 0) rsq[(size_t)row * 16 + u.pn * 4 + wc] = ss; }
        }
    }
};
struct EpiSq {
    static constexpr bool PERM = true, AFTER_DRAIN = false;
    bf16_t* Hd; const float* rsq; const float* cv; int row_off;
    __device__ __forceinline__ void operator()(const f32x4 (&acc)[2][2][4][2], const pg8::Unit& u, int wr, int wc, int fr, int fq) const {
        const int row0 = u.pm * 256 + wr * 64 + fr, col0 = u.pn * 256 + wc * 32 + 8 * fq;
        const int rowu = row_off + u.pm * 256; const float* cvp = cv + (size_t)(rowu < MC ? 16 : ((rowu - MC) >> 11)) * DFF + col0;
        f32x4 c4[2][2];
#pragma unroll
        for (int bj = 0; bj < 2; ++bj)
#pragma unroll
            for (int n = 0; n < 2; ++n) c4[bj][n] = *(const f32x4*)(cvp + bj * 128 + n * 4);
        float rsv[2][4]; epi_row_scales(rsq, row0 + row_off, fq, rsv);
#pragma unroll
        for (int ai = 0; ai < 2; ++ai)
#pragma unroll
            for (int m = 0; m < 4; ++m) { const int rel = row0 + ai * 128 + m * 16; bf16_t* rp = Hd + (size_t)rel * DFF + col0;
                const float rs = rsv[ai][m];
#pragma unroll
                for (int bj = 0; bj < 2; ++bj) { f32x4 v0 = acc[ai][bj][m][0] * rs + c4[bj][0], v1 = acc[ai][bj][m][1] * rs + c4[bj][1];
#pragma unroll
                    for (int j = 0; j < 4; ++j) { const float r0 = v0[j] > 0.f ? v0[j] : 0.f, r1 = v1[j] > 0.f ? v1[j] : 0.f; v0[j] = r0 * r0; v1[j] = r1 * r1; }
                    u32x4 o; o.x = pk2(v0[0], v0[1]); o.y = pk2(v0[2], v0[3]); o.z = pk2(v1[0], v1[1]); o.w = pk2(v1[2], v1[3]); *(u32x4*)(rp + bj * 128) = o; } }
    }
};

__device__ __forceinline__ void phase_adaln(const Params& p, LAS unsigned char* lds, int bid, int G) {
    const int tid = opaque_tid(), wave = tid >> 6, lane = tid & 63;
    LAS float* sc = (LAS float*)lds;
    LAS float* red = sc + 17 * 1024;
    float* MOD = (float*)(p.ws + WS_MOD);
    if (bid == 0 && tid < 256) ((unsigned*)(p.ws + WS_CTR))[tid] = 0u;
    for (int i = tid; i < 17 * 1024; i += NT) { const int bi = i >> 10, k = i & 1023; const float c = bi < 16 ? p.in[I_C][bi * 1024 + k] : p.in[I_CCTX][k]; sc[i] = c * sigmoidf_(c); }
    __syncthreads();
    for (int item = bid; item < 192; item += G) {
        const int l = item / 48, j0 = (item % 48) * 128;
        float acc[17], acd[17];
#pragma unroll
        for (int bi = 0; bi < 17; ++bi) { acc[bi] = 0.f; acd[bi] = 0.f; }
        const float* w = p.in[I_ADAW] + ((size_t)l * 1024 + wave * 128) * 6144 + j0 + lane;
        for (int k0 = 0; k0 < 128; k0 += 8) { float a[8], c[8];
#pragma unroll
            for (int j = 0; j < 8; ++j) { a[j] = __builtin_nontemporal_load(w + (size_t)(k0 + j) * 6144); c[j] = __builtin_nontemporal_load(w + (size_t)(k0 + j) * 6144 + 64); }
#pragma unroll
            for (int j = 0; j < 8; ++j) { const int k = wave * 128 + k0 + j;
#pragma unroll
                for (int bi = 0; bi < 17; ++bi) { const float sv = sc[bi * 1024 + k]; acc[bi] += sv * a[j]; acd[bi] += sv * c[j]; } } }
#pragma unroll
        for (int half = 0; half < 2; ++half) {
#pragma unroll
            for (int bi = 0; bi < 17; ++bi) red[(wave * 17 + bi) * 64 + lane] = half ? acd[bi] : acc[bi];
            __syncthreads();
            for (int i = tid; i < 17 * 64; i += NT) { const int bi = i >> 6, ln = i & 63; float sum = 0.f;
#pragma unroll
                for (int w8 = 0; w8 < 8; ++w8) sum += red[(w8 * 17 + bi) * 64 + ln];
                MOD[((size_t)l * 17 + bi) * 6144 + j0 + half * 64 + ln] = sum + p.in[I_ADAB][l * 6144 + j0 + half * 64 + ln]; }
            __syncthreads();
        }
    }
    float* ROPE = (float*)(p.ws + WS_ROPE);
    for (int idx = bid * NT + tid; idx < SEQ * 32; idx += G * NT) { const int pos = idx >> 5, i = idx & 31, f = i & 15;
        const float inv = powf(10000.f, -(float)f / 16.f); const float ang = (float)(i < 16 ? (pos >> 6) : (pos & 63)) * inv;
        const float n = rintf(ang * 0.15915494309189535f); float r = fmaf(-n, 6.28318548202514648f, ang); r = fmaf(-n, -1.7484555e-7f, r);
        ROPE[2 * idx] = cosf(r); ROPE[2 * idx + 1] = sinf(r); }
}

__device__ __forceinline__ void transpose_item(const float* W, int K, int N, bf16_t* WT, LAS float* scr, int item, int lane) {
    const int nblk = (N + 31) / 32, kb = item / nblk, nb = item % nblk, k0 = 64 * kb, n0 = 32 * nb;
    const int nn = n0 + (lane & 31); const bool ok = nn < N;
#pragma unroll 8
    for (int i = 0; i < 32; ++i) { const int kk = 2 * i + (lane >> 5); scr[kk * 33 + (lane & 31)] = ok ? W[(size_t)(k0 + kk) * N + nn] : 0.f; }
    LDS_WAIT();
    const int c = lane & 7;
#pragma unroll
    for (int j = 0; j < 4; ++j) { const int n = (lane >> 3) + 8 * j; const LAS float* s = scr + (8 * c) * 33 + n;
        u32x4 o; o.x = pk2(s[0 * 33], s[1 * 33]); o.y = pk2(s[2 * 33], s[3 * 33]); o.z = pk2(s[4 * 33], s[5 * 33]); o.w = pk2(s[6 * 33], s[7 * 33]);
        *(u32x4*)(WT + (size_t)(n0 + n) * K + k0 + 8 * c) = o; }
    LDS_WAIT();
}
constexpr int CW_I1 = 16 * 93, CW_I2 = 16 * 32, CW_I3 = 16 * 128, CW_I4 = 64 * 32, CW_I123 = CW_I1 + CW_I2 + CW_I3, CW_ITOT = CW_I123 + CW_I4;
__device__ __forceinline__ void convert_weights(const Params& p, int l, LAS unsigned char* lds, int it_lo, int it_hi, int bi, int ncb) {
    const int tid = opaque_tid(), wave = tid >> 6, lane = tid & 63;
    LAS float* scr = (LAS float*)(lds + wave * 8448);
    for (int it = bi < ncb ? it_lo + bi * 8 + wave : it_hi; it < it_hi; it += ncb * 8) {
        int r = it;
        if (r < CW_I1) { transpose_item(p.in[I_WIN] + (size_t)l * D * NIN, D, NIN, (bf16_t*)(p.ws + WS_WIN), scr, r, lane); continue; } r -= CW_I1;
        if (r < CW_I2) { transpose_item(p.in[I_WOUT] + (size_t)l * D * D, D, D, (bf16_t*)(p.ws + WS_WOUT), scr, r, lane); continue; } r -= CW_I2;
        if (r < CW_I3) { transpose_item(p.in[I_W1] + (size_t)l * D * DFF, D, DFF, (bf16_t*)(p.ws + WS_W1), scr, r, lane); continue; } r -= CW_I3;
        transpose_item(p.in[I_W2] + (size_t)l * DFF * D, DFF, D, (bf16_t*)(p.ws + WS_W2), scr, r, lane);
    }
}

__device__ __forceinline__ void phase_norm(const Params& p, int l, int which, int row_lo, int bid, int G) {
    const int tid = opaque_tid(), wave = tid >> 6, lane = tid & 63;
    const float* MOD = (const float*)(p.ws + WS_MOD) + (size_t)l * 17 * 6144;
    float* Xc = (float*)(p.ws + WS_XC); bf16_t* H = (bf16_t*)(p.ws + WS_H);
    const float* gsrc = (which ? p.in[I_N2G] : p.in[I_N1G]) + l * D;
    const bool first = (l == 0 && which == 0);
    for (int row = row_lo + bid * 8 + wave; row < M; row += G * 8) {
        const float* src = first ? (row < MC ? p.in[I_CTX] + (size_t)row * D : p.in[I_X] + (size_t)(row - MC) * D)
                                 : (row < MC ? Xc + (size_t)row * D : p.out + (size_t)(row - MC) * D);
        f32x4 v[4]; float ss = 0.f;
#pragma unroll
        for (int j = 0; j < 4; ++j) { v[j] = *(const f32x4*)(src + 4 * lane + 256 * j); ss += v[j][0] * v[j][0] + v[j][1] * v[j][1] + v[j][2] * v[j][2] + v[j][3] * v[j][3]; }
        ss = wave_sum(ss); const float rs = rsqrtf(ss * (1.f / D) + 1e-6f);
        if (first) { float* dst = row < MC ? Xc + (size_t)row * D : p.out + (size_t)(row - MC) * D;
#pragma unroll
            for (int j = 0; j < 4; ++j) *(f32x4*)(dst + 4 * lane + 256 * j) = v[j]; }
        const int bi = row < MC ? 16 : ((row - MC) >> 11);
        const float* sh = MOD + (size_t)bi * 6144 + (which ? 3 : 0) * 1024; const float* scl = sh + 1024;
#pragma unroll
        for (int j = 0; j < 4; ++j) { const int col = 4 * lane + 256 * j;
            const f32x4 g = *(const f32x4*)(gsrc + col), s1 = *(const f32x4*)(scl + col), s0 = *(const f32x4*)(sh + col);
            float y[4];
#pragma unroll
            for (int e = 0; e < 4; ++e) y[e] = (v[j][e] * rs * g[e]) * (1.f + s1[e]) + s0[e];
            u32x2 o; o.x = pk2(y[0], y[1]); o.y = pk2(y[2], y[3]); *(u32x2*)(H + (size_t)row * D + col) = o; }
    }
}
__device__ __forceinline__ void phase_cvec(const Params& p, int l, LAS unsigned char* lds, int bid, int G) {
    const int tid = opaque_tid(), wave = tid >> 6, lane = tid & 63;
    LAS float* sc = (LAS float*)lds; LAS float* red = sc + 17 * 1024;
    const float* MODl = (const float*)(p.ws + WS_MOD) + (size_t)l * 17 * 6144;
    for (int item = G - 1 - bid; item < 111; item += G) {
        const bool second = item >= 47; const int j0 = (second ? item - 47 : item) * 64, N = second ? DFF : NIN, ldo = second ? DFF : NINP;
        const float* W = second ? p.in[I_W1] + (size_t)l * D * DFF : p.in[I_WIN] + (size_t)l * D * NIN;
        float* out = (float*)(p.ws + (second ? WS_CV2 : WS_CV1));
        __syncthreads();
        for (int i = tid; i < 17 * 1024; i += NT) { const int bi = i >> 10, k = i & 1023; sc[i] = MODl[(size_t)bi * 6144 + (second ? 3 : 0) * 1024 + k]; }
        __syncthreads();
        float acc[17];
#pragma unroll
        for (int bi = 0; bi < 17; ++bi) acc[bi] = 0.f;
        const int n = j0 + lane; const bool ok = n < N;
        for (int k0 = 0; k0 < 128; k0 += 16) { float a[16];
#pragma unroll
            for (int j = 0; j < 16; ++j) a[j] = ok ? W[(size_t)(wave * 128 + k0 + j) * N + n] : 0.f;
#pragma unroll
            for (int j = 0; j < 16; ++j) { const int k = wave * 128 + k0 + j;
#pragma unroll
                for (int bi = 0; bi < 17; ++bi) acc[bi] += sc[bi * 1024 + k] * a[j]; } }
#pragma unroll
        for (int bi = 0; bi < 17; ++bi) red[(wave * 17 + bi) * 64 + lane] = acc[bi];
        __syncthreads();
        for (int i = tid; i < 17 * 64; i += NT) { const int bi = i >> 6, ln = i & 63; float sum = 0.f;
#pragma unroll
            for (int w8 = 0; w8 < 8; ++w8) sum += red[(w8 * 17 + bi) * 64 + ln];
            if (j0 + ln < N) out[(size_t)bi * ldo + j0 + ln] = sum; }
    }
    __syncthreads();
}
__device__ __forceinline__ void phase_boot(const Params& p, int bid, int G) {
    const int tid = opaque_tid(), wave = tid >> 6, lane = tid & 63;
    const float* MOD = (const float*)(p.ws + WS_MOD);
    float* Xc = (float*)(p.ws + WS_XC); bf16_t* H = (bf16_t*)(p.ws + WS_H); float* rsq = (float*)(p.ws + WS_RSQ1);
    for (int row = bid * 8 + wave; row < M; row += G * 8) {
        const float* src = row < MC ? p.in[I_CTX] + (size_t)row * D : p.in[I_X] + (size_t)(row - MC) * D;
        float* dst = row < MC ? Xc + (size_t)row * D : p.out + (size_t)(row - MC) * D;
        const float* scl = MOD + (size_t)(row < MC ? 16 : ((row - MC) >> 11)) * 6144 + 1024;
        float ss = 0.f;
#pragma unroll
        for (int j = 0; j < 4; ++j) { const int col = 4 * lane + 256 * j; const f32x4 v = *(const f32x4*)(src + col); *(f32x4*)(dst + col) = v;
            ss += (v[0] * v[0] + v[1] * v[1]) + (v[2] * v[2] + v[3] * v[3]);
            const f32x4 g = *(const f32x4*)(p.in[I_N1G] + col), s1 = *(const f32x4*)(scl + col); const f32x4 hv = v * (g * (s1 + 1.f));
            u32x2 o; o.x = pk2(hv[0], hv[1]); o.y = pk2(hv[2], hv[3]); *(u32x2*)(H + (size_t)row * D + col) = o; }
        ss = wave_sum(ss); if (lane < 16) rsq[(size_t)row * 16 + lane] = lane == 0 ? ss : 0.f;
    }
}
__device__ __forceinline__ void zero_f32(float* ptr, int n, int bid, int G) { for (int i = bid * NT + opaque_tid(); i < n; i += G * NT) ptr[i] = 0.f; }
__device__ __forceinline__ void phase_final(const Params& p, int bid, int G) {
    const int tid = opaque_tid(), wave = tid >> 6, lane = tid & 63;
    for (int row = bid * 8 + wave; row < ML; row += G * 8) { float* xr = p.out + (size_t)row * D;
        f32x4 v[4]; float ss = 0.f;
#pragma unroll
        for (int j = 0; j < 4; ++j) { v[j] = *(const f32x4*)(xr + 4 * lane + 256 * j); ss += v[j][0] * v[j][0] + v[j][1] * v[j][1] + v[j][2] * v[j][2] + v[j][3] * v[j][3]; }
        ss = wave_sum(ss); const float rs = rsqrtf(ss * (1.f / D) + 1e-6f);
#pragma unroll
        for (int j = 0; j < 4; ++j) { const int col = 4 * lane + 256 * j; const f32x4 g = *(const f32x4*)(p.in[I_FG] + col);
            f32x4 o; o[0] = v[j][0] * rs * g[0]; o[1] = v[j][1] * rs * g[1]; o[2] = v[j][2] * rs * g[2]; o[3] = v[j][3] * rs * g[3]; *(f32x4*)(xr + col) = o; }
    }
}

__device__ __forceinline__ void convert_lora(const Params& p, int l, int bid, int G) {
    const int tid = opaque_tid(); bf16_t* LW = (bf16_t*)(p.ws + WS_LW);
    for (int idx = bid * NT + tid; idx < 98304; idx += G * NT) { float v;
        if (idx < 65536) { const int sub = idx >> 14, n = (idx >> 6) & 255, k = idx & 63;
            v = (sub < 2 ? p.in[I_RWUP] + ((size_t)l * 2 + sub) * 16384 : p.in[I_RAUP] + ((size_t)l * 2 + (sub - 2)) * 16384)[k * 256 + n]; }
        else { const int j = idx - 65536, n = j >> 7, k = j & 127; v = p.in[I_RGUP][(size_t)l * 32768 + k * 256 + n]; }
        LW[idx] = (bf16_t)f2bf(v); }
}
__device__ __forceinline__ void phase_prep(const Params& p, int l, LAS unsigned char* lds, int bid, int G) {
    const int tid = opaque_tid(), wave = tid >> 6, lane = tid & 63, fr = lane & 15, fq = lane >> 4;
    constexpr int PTR = 144;
    const bf16_t* P1 = (const bf16_t*)(p.ws + WS_P1); const bf16_t* LW = (const bf16_t*)(p.ws + WS_LW);
    bf16_t* RKV = (bf16_t*)(p.ws + WS_RKV); unsigned short* WD = (unsigned short*)(p.ws + WS_WD); bf16_t* AD = (bf16_t*)(p.ws + WS_AD); bf16_t* Gb = (bf16_t*)(p.ws + WS_G);
    LAS bf16_t* At = (LAS bf16_t*)lds;
    LAS bf16_t* Bt = (LAS bf16_t*)(lds + PTR * 136 * 2);
    LAS float* bias_s = (LAS float*)(lds + PTR * 136 * 2 + 256 * 136 * 2);
    const float* cw = p.in[I_RCONV] + (size_t)l * 3 * 768;
    for (int tile = bid; tile < M / PTR; tile += G) {
        const int row0 = tile * PTR;
        if (tid < 480) { const int c = (tid % 96) * 8, seg = tid / 96; const int rb = seg * 29, re = rb + 29 < PTR ? rb + 29 : PTR;
            float w0[8], w1[8], w2[8];
#pragma unroll
            for (int e = 0; e < 8; ++e) { w0[e] = cw[c + e]; w1[e] = cw[768 + c + e]; w2[e] = cw[1536 + c + e]; }
            const u32x4 z4 = {0u, 0u, 0u, 0u};
            for (int r0 = rb; r0 < re; r0 += 8) {
                u32x4 rw[10];
#pragma unroll
                for (int j = 0; j < 10; ++j) { const int row = row0 + r0 - 1 + j; rw[j] = (row >= 0 && row < M && r0 - 1 + j <= re) ? *(const u32x4*)(P1 + (size_t)row * P1W + c) : z4; }
#pragma unroll
                for (int j = 0; j < 8; ++j) { const int row = row0 + r0 + j;
                    if (r0 + j < re) { const int pos = row < MC ? (row & 255) : ((row - MC) & 2047), len = row < MC ? 256 : 2048;
                        float a[8], b[8], d[8], o[8]; unpack8(pos > 0 ? rw[j] : z4, a); unpack8(rw[j + 1], b); unpack8(pos < len - 1 ? rw[j + 2] : z4, d);
#pragma unroll
                        for (int e = 0; e < 8; ++e) o[e] = a[e] * w0[e] + b[e] * w1[e] + d[e] * w2[e];
                        *(u32x4*)(RKV + (size_t)row * 768 + c) = pack8(o); } } } }
        for (int sub = 0; sub < 5; ++sub) {
            const int K = sub < 4 ? 64 : 128, pitch = K + 8, k8 = K / 8;
            const int zoff = 768 + (sub < 2 ? sub * 64 : (sub < 4 ? 128 + (sub - 2) * 64 : 256));
            const bf16_t* Bsrc = LW + (sub < 4 ? sub * 16384 : 65536);
            __syncthreads();
            for (int i0 = tid; i0 < PTR * k8; i0 += 3 * NT) {
                u32x4 zz[3];
#pragma unroll
                for (int j = 0; j < 3; ++j) { const int i = i0 + j * NT; const int r = i / k8, kc = (i % k8) * 8;
                    zz[j] = i < PTR * k8 ? *(const u32x4*)(P1 + (size_t)(row0 + r) * P1W + zoff + kc) : (u32x4){0u, 0u, 0u, 0u}; }
#pragma unroll
                for (int j = 0; j < 3; ++j) { const int i = i0 + j * NT; if (i < PTR * k8) { const int r = i / k8, kc = (i % k8) * 8; float f[8]; unpack8(zz[j], f);
                    if (sub < 2) {
#pragma unroll
                        for (int e = 0; e < 8; ++e) { const float ex = __expf(2.f * f[e]); f[e] = 1.f - 2.f * __builtin_amdgcn_rcpf(ex + 1.f); }
                    } else if (sub == 4) {
#pragma unroll
                        for (int e = 0; e < 8; ++e) f[e] = sigmoidf_(f[e]);
                    }
                    *(LAS u32x4*)(At + r * pitch + kc) = pack8(f); } } }
            for (int i0 = tid; i0 < 256 * k8; i0 += 4 * NT) { u32x4 bb[4];
#pragma unroll
                for (int j = 0; j < 4; ++j) { const int i = i0 + j * NT; bb[j] = *(const u32x4*)(Bsrc + (size_t)(i / k8) * K + (i % k8) * 8); }
#pragma unroll
                for (int j = 0; j < 4; ++j) { const int i = i0 + j * NT; *(LAS u32x4*)(Bt + (i / k8) * pitch + (i % k8) * 8) = bb[j]; } }
            if (tid < 256 && sub < 4) bias_s[tid] = (sub < 2 ? p.in[I_RW0] + ((size_t)l * 2 + sub) * 256 : p.in[I_RA0] + ((size_t)l * 2 + (sub - 2)) * 256)[tid];
            __syncthreads();
            for (int it = wave * 9; it < wave * 9 + 9; ++it) { const int mt = it >> 3, ng = it & 7;
                bf16x8 af[4];
#pragma unroll
                for (int kk = 0; kk < 4; ++kk) if (kk * 32 < K) af[kk] = *(const LAS bf16x8*)(At + (mt * 16 + fr) * pitch + kk * 32 + fq * 8);
                const int row = row0 + mt * 16 + fr;
#pragma unroll
                for (int n2 = 0; n2 < 2; ++n2) { const int nt = ng * 2 + n2;
                    f32x4 acc = {0.f, 0.f, 0.f, 0.f};
#pragma unroll
                    for (int kk = 0; kk < 4; ++kk) if (kk * 32 < K) { const bf16x8 bfr = *(const LAS bf16x8*)(Bt + (nt * 16 + fr) * pitch + kk * 32 + fq * 8);
                        acc = __builtin_amdgcn_mfma_f32_16x16x32_bf16(bfr, af[kk], acc, 0, 0, 0); }
                    const int col = nt * 16 + 4 * fq;
                    if (sub < 2) { const f32x4 w0 = *(const LAS f32x4*)(bias_s + col); unsigned h[4];
#pragma unroll
                        for (int j = 0; j < 4; ++j) h[j] = f2h(__expf(-0.606531f * sigmoidf_(w0[j] + acc[j])));
                        u32x2 o; o.x = h[0] | (h[1] << 16); o.y = h[2] | (h[3] << 16); *(u32x2*)(WD + ((size_t)sub * M + row) * 256 + col) = o;
                    } else if (sub < 4) { const f32x4 a0 = *(const LAS f32x4*)(bias_s + col);
                        u32x2 o; o.x = pk2(sigmoidf_(a0[0] + acc[0]), sigmoidf_(a0[1] + acc[1])); o.y = pk2(sigmoidf_(a0[2] + acc[2]), sigmoidf_(a0[3] + acc[3]));
                        *(u32x2*)(AD + ((size_t)(sub - 2) * M + row) * 256 + col) = o;
                    } else { u32x2 o; o.x = pk2(acc[0], acc[1]); o.y = pk2(acc[2], acc[3]); *(u32x2*)(Gb + (size_t)row * 256 + col) = o; }
                }
            }
        }
        __syncthreads();
    }
}

__device__ __forceinline__ void rwkv_chain(const Params& p, int l, int chain, LAS unsigned char* lds) {
    const int tid = opaque_tid();
    const int b = chain >> 3, h = (chain >> 1) & 3, dir = chain & 1;
    constexpr int CH = 32, NCH = (TC + SEQ) / CH, ASZ = CH * 64, BSZ = 6 * ASZ;
    LAS float* base = (LAS float*)lds;
    LAS float* ybuf = base + 2 * BSZ;
    const bf16_t* RKV = (const bf16_t*)(p.ws + WS_RKV); const unsigned short* WD = (const unsigned short*)(p.ws + WS_WD) + (size_t)dir * M * 256;
    const bf16_t* AD = (const bf16_t*)(p.ws + WS_AD) + (size_t)dir * M * 256;
    float* YR = (float*)(p.ws + WS_H) + (size_t)dir * M * 256;
    const bool producer = tid >= 256;
    const int tk = (tid >> 3) & 31, c8 = (tid & 7) * 8, ch = h * 64 + c8;
    float kkw[8], kaw[8];
#pragma unroll
    for (int e = 0; e < 8; ++e) { kkw[e] = p.in[I_RKK][l * 256 + ch + e]; kaw[e] = p.in[I_RKA][l * 256 + ch + e]; }
    const int kj = tid & 7, vg = (tid >> 3) & 31;
    f32x4 S0a = {0.f, 0.f, 0.f, 0.f}, S0b = S0a, S1a = S0a, S1b = S0a;
#define RW_STAGE(ci_) { const size_t row = (size_t)chain_row(b, dir, (ci_) * CH + tk); \
        const u32x4 rr = *(const u32x4*)(RKV + row * 768 + ch), rk = *(const u32x4*)(RKV + row * 768 + 256 + ch), rv = *(const u32x4*)(RKV + row * 768 + 512 + ch), \
                    ra = *(const u32x4*)(AD + row * 256 + ch), rw = *(const u32x4*)(WD + row * 256 + ch); \
        LAS float* Rs = base + ((ci_) & 1) * BSZ; LAS float* Ws = Rs + ASZ; LAS float* KDs = Ws + ASZ; LAS float* KKs = KDs + ASZ; LAS float* Bs = KKs + ASZ; LAS float* Vs = Bs + ASZ; \
        float r[8], k[8], vv[8], a[8], w[8], kx[8]; unpack8(rr, r); unpack8(rk, k); unpack8(rv, vv); unpack8(ra, a); \
        w[0] = h2f(rw.x & 0xffffu); w[1] = h2f(rw.x >> 16); w[2] = h2f(rw.y & 0xffffu); w[3] = h2f(rw.y >> 16); w[4] = h2f(rw.z & 0xffffu); w[5] = h2f(rw.z >> 16); w[6] = h2f(rw.w & 0xffffu); w[7] = h2f(rw.w >> 16); \
        float ss = 0.f; \
        _Pragma("unroll") for (int e = 0; e < 8; ++e) { kx[e] = k[e] * kkw[e]; ss += kx[e] * kx[e]; } \
        ss = row8_sum(ss); \
        const float inv = rsqrtf(ss + 1e-12f); \
        float kd[8], kk[8], bb[8]; \
        _Pragma("unroll") for (int e = 0; e < 8; ++e) { kk[e] = kx[e] * inv; kd[e] = k[e] * (1.f + (a[e] - 1.f) * kaw[e]); bb[e] = kk[e] * a[e]; } \
        const int o = tk * 64 + c8; \
        *(LAS f32x4*)(Rs + o) = (f32x4){r[0], r[1], r[2], r[3]}; *(LAS f32x4*)(Rs + o + 4) = (f32x4){r[4], r[5], r[6], r[7]}; \
        *(LAS f32x4*)(Ws + o) = (f32x4){w[0], w[1], w[2], w[3]}; *(LAS f32x4*)(Ws + o + 4) = (f32x4){w[4], w[5], w[6], w[7]}; \
        *(LAS f32x4*)(KDs + o) = (f32x4){kd[0], kd[1], kd[2], kd[3]}; *(LAS f32x4*)(KDs + o + 4) = (f32x4){kd[4], kd[5], kd[6], kd[7]}; \
        *(LAS f32x4*)(KKs + o) = (f32x4){kk[0], kk[1], kk[2], kk[3]}; *(LAS f32x4*)(KKs + o + 4) = (f32x4){kk[4], kk[5], kk[6], kk[7]}; \
        *(LAS f32x4*)(Bs + o) = (f32x4){bb[0], bb[1], bb[2], bb[3]}; *(LAS f32x4*)(Bs + o + 4) = (f32x4){bb[4], bb[5], bb[6], bb[7]}; \
        *(LAS f32x4*)(Vs + o) = (f32x4){vv[0], vv[1], vv[2], vv[3]}; *(LAS f32x4*)(Vs + o + 4) = (f32x4){vv[4], vv[5], vv[6], vv[7]}; }
#define RW_FLUSH(cf_) { const int rowf = chain_row(b, dir, (cf_) * CH + tk); const LAS float* ys = ybuf + ((cf_) & 1) * ASZ + tk * 64 + c8; \
        const f32x4 y0 = *(const LAS f32x4*)ys, y1 = *(const LAS f32x4*)(ys + 4); float* yd = YR + (size_t)rowf * 256 + ch; *(f32x4*)yd = y0; *(f32x4*)(yd + 4) = y1; }
    __syncthreads();
    if (producer) RW_STAGE(0)
    __syncthreads();
    for (int ci = 0; ci < NCH; ++ci) {
        if (producer) { if (ci + 1 < NCH) RW_STAGE(ci + 1)
            if (ci > 0) RW_FLUSH(ci - 1) }
        else {
            LAS float* Rs = base + (ci & 1) * BSZ; LAS float* Ws = Rs + ASZ; LAS float* KDs = Ws + ASZ; LAS float* KKs = KDs + ASZ; LAS float* Bs = KKs + ASZ; LAS float* Vs = Bs + ASZ;
            const int row0 = chain_row(b, dir, ci * CH), sgn = dir ? -1 : 1;
            const int ok = 8 * kj, ov = 2 * vg;
#define RW_LD(dst, arr, o) dst##a = *(const LAS f32x4*)(arr + (o) + ok); dst##b = *(const LAS f32x4*)(arr + (o) + ok + 4)
#define RW_LOADSET(X, o) RW_LD(kk##X, KKs, o); RW_LD(w##X, Ws, o); RW_LD(b##X, Bs, o); RW_LD(kd##X, KDs, o); RW_LD(r##X, Rs, o); v##X = *(const LAS f32x2*)(Vs + (o) + ov)
#define RW_STEP(T, C, N) { RW_LOADSET(N, ((T) + 1) * 64); \
                f32x4 p0 = S0a * kk##C##a + S0b * kk##C##b, p1 = S1a * kk##C##a + S1b * kk##C##b; \
                const float sa0 = row8_sum((p0[0] + p0[1]) + (p0[2] + p0[3])), sa1 = row8_sum((p1[0] + p1[1]) + (p1[2] + p1[3])); \
                S0a = S0a * w##C##a + (kd##C##a * v##C[0] - b##C##a * sa0); S0b = S0b * w##C##b + (kd##C##b * v##C[0] - b##C##b * sa0); \
                S1a = S1a * w##C##a + (kd##C##a * v##C[1] - b##C##a * sa1); S1b = S1b * w##C##b + (kd##C##b * v##C[1] - b##C##b * sa1); \
                p0 = S0a * r##C##a + S0b * r##C##b; p1 = S1a * r##C##a + S1b * r##C##b; \
                f32x2 y; y[0] = row8_sum((p0[0] + p0[1]) + (p0[2] + p0[3])); y[1] = row8_sum((p1[0] + p1[1]) + (p1[2] + p1[3])); \
                *(LAS f32x2*)(ybuf + (ci & 1) * ASZ + (T) * 64 + ov) = y; }
            f32x4 kkAa, kkAb, wAa, wAb, bAa, bAb, kdAa, kdAb, rAa, rAb, kkBa, kkBb, wBa, wBb, bBa, bBb, kdBa, kdBb, rBa, rBb; f32x2 vA, vB;
            RW_LOADSET(A, 0);
            for (int t = 0; t < CH; t += 2) { RW_STEP(t, A, B) RW_STEP(t + 1, B, A) }
#undef RW_STEP
#undef RW_LOADSET
#undef RW_LD
        }
        __syncthreads();
    }
    if (producer) RW_FLUSH(NCH - 1)
    __syncthreads();
#undef RW_FLUSH
#undef RW_STAGE
}

__device__ __forceinline__ float log_sigmoid_(float x) { return fminf(x, 0.f) - log1pf(__expf(-fabsf(x))); }
__device__ __forceinline__ void mlstm_chain(const Params& p, int l, int chain, LAS unsigned char* lds) {
    const int tid = opaque_tid(), wave = tid >> 6, lane = tid & 63, fr = lane & 15, fq = lane >> 4;
    const int b = chain >> 3, h = (chain >> 1) & 3, dir = chain & 1;
    constexpr int PT = 72;
    LAS bf16_t* Qs = (LAS bf16_t*)lds; LAS bf16_t* Ks = Qs + 64 * PT; LAS bf16_t* Kt = Ks + 64 * PT; LAS bf16_t* Vt = Kt + 64 * PT; LAS bf16_t* Ss = Vt + 64 * PT; LAS bf16_t* Cs = Ss + 64 * PT;
    LAS float* fb = (LAS float*)(lds + 6 * 64 * PT * 2);
    LAS float* ib = fb; LAS float* mxs = fb + 64; LAS float* wint = fb + 128; LAS float* emt = fb + 192; LAS float* gw = fb + 256; LAS float* nvec = fb + 320; LAS float* nq = fb + 384;
    LAS float* dsum = fb + 448;   LAS float* scal = fb + 576;
    const bf16_t* P2 = (const bf16_t*)(p.ws + WS_P2);
    bf16_t* YM = (bf16_t*)(p.ws + WS_YM) + (size_t)dir * M * 256;
    const float* cw = p.in[I_MCONV] + (size_t)l * 3 * 512;
    const float bi_ = p.in[I_MBI][l * 8 + dir * 4 + h], bf_ = p.in[I_MBF][l * 8 + dir * 4 + h];
    for (int i = tid; i < 64 * PT; i += NT) Cs[i] = 0;
    if (tid < 64) nvec[tid] = 0.f;
    if (tid == 0) { scal[0] = 0.f; scal[1] = 0.f; }
    f32x4 accC[2] = {{0.f, 0.f, 0.f, 0.f}, {0.f, 0.f, 0.f, 0.f}};
    const int tA = wave >> 1, tB0 = 2 * (wave & 1);
    for (int ci = 0; ci < 36; ++ci) {
        __syncthreads();
        { const int t = tid >> 3, c8 = (tid & 7) * 8; const int row = chain_row(b, dir, ci * 64 + t);
          const int pos = row < MC ? (row & 255) : ((row - MC) & 2047), len = row < MC ? 256 : 2048;
          const u32x4 z4 = {0u, 0u, 0u, 0u};
          const bf16_t* base = P2 + (size_t)row * P2W;
#pragma unroll
          for (int part = 0; part < 2; ++part) { const int col = 768 + part * 256 + h * 64 + c8; const int wc = part * 256 + h * 64 + c8;
              const u32x4 cur = *(const u32x4*)(base + col);
              const u32x4 prv = pos > 0 ? *(const u32x4*)(base - P2W + col) : z4;
              const u32x4 nxt = pos < len - 1 ? *(const u32x4*)(base + P2W + col) : z4;
              float a[8], bb[8], d[8], o[8]; unpack8(prv, a); unpack8(cur, bb); unpack8(nxt, d);
#pragma unroll
              for (int e = 0; e < 8; ++e) { const float x = a[e] * cw[wc + e] + bb[e] * cw[512 + wc + e] + d[e] * cw[1024 + wc + e]; const float s = x * sigmoidf_(x); o[e] = part ? s * 0.125f : s; }
              const u32x4 pk = pack8(o);
              if (part == 0) *(LAS u32x4*)(Qs + t * PT + c8) = pk;
              else { *(LAS u32x4*)(Ks + t * PT + c8) = pk;
#pragma unroll
                  for (int e = 0; e < 8; ++e) Kt[(c8 + e) * PT + t] = (bf16_t)f2bf(o[e]); } }
          const u32x4 vr = *(const u32x4*)(base + 1280 + h * 64 + c8);
          Vt[(c8 + 0) * PT + t] = (bf16_t)(vr.x & 0xffffu); Vt[(c8 + 1) * PT + t] = (bf16_t)(vr.x >> 16); Vt[(c8 + 2) * PT + t] = (bf16_t)(vr.y & 0xffffu); Vt[(c8 + 3) * PT + t] = (bf16_t)(vr.y >> 16);
          Vt[(c8 + 4) * PT + t] = (bf16_t)(vr.z & 0xffffu); Vt[(c8 + 5) * PT + t] = (bf16_t)(vr.z >> 16); Vt[(c8 + 6) * PT + t] = (bf16_t)(vr.w & 0xffffu); Vt[(c8 + 7) * PT + t] = (bf16_t)(vr.w >> 16); }
        if (wave == 0) { const int row = chain_row(b, dir, ci * 64 + lane); const bf16_t* gp = P2 + (size_t)row * P2W + 1792;
            const float ig = bf2f(gp[dir * 4 + h]) + bi_, fg = log_sigmoid_(bf2f(gp[8 + dir * 4 + h]) + bf_);
            float bc = fg;
#pragma unroll
            for (int o = 1; o < 64; o <<= 1) { const float u = __shfl_up(bc, o); if (lane >= o) bc += u; }
            const float ibv = ig - bc; float pm = ibv;
#pragma unroll
            for (int o = 1; o < 64; o <<= 1) { const float u = __shfl_up(pm, o); if (lane >= o) pm = fmaxf(pm, u); }
            const float m = scal[0]; const float mx = fmaxf(m, pm); const float mx63 = __shfl(mx, 63), b63 = __shfl(bc, 63);
            ib[lane] = ibv; mxs[lane] = mx; wint[lane] = __expf(m - mx); emt[lane] = __expf(-(bc + mx)); gw[lane] = __expf(ibv - mx63);
            LDS_WAIT();
            if (lane == 0) { scal[1] = __expf(m - mx63); scal[0] = b63 + mx63; } }
        __syncthreads();
        {
#pragma unroll
            for (int ct = 0; ct < 2; ++ct) { const int st = tB0 + ct; f32x4 acc = {0.f, 0.f, 0.f, 0.f};
#pragma unroll
                for (int kk = 0; kk < 2; ++kk) { const bf16x8 a = *(const LAS bf16x8*)(Qs + (tA * 16 + fr) * PT + kk * 32 + fq * 8); const bf16x8 bq = *(const LAS bf16x8*)(Ks + (st * 16 + fr) * PT + kk * 32 + fq * 8);
                    acc = __builtin_amdgcn_mfma_f32_16x16x32_bf16(a, bq, acc, 0, 0, 0); }
                const int s = st * 16 + fr; const float ibs = ib[s];
                float rs[4];
#pragma unroll
                for (int j = 0; j < 4; ++j) { const int t = tA * 16 + fq * 4 + j; const float wv = s <= t ? __expf(ibs - mxs[t]) : 0.f; const float sv = acc[j] * wv; rs[j] = sv; Ss[t * PT + s] = (bf16_t)f2bf(sv); }
#pragma unroll
                for (int j = 0; j < 4; ++j) { float r = rs[j]; r = row16_sum(r); rs[j] = r; }
                if (fr == 0) {
#pragma unroll
                    for (int j = 0; j < 4; ++j) { const int t = tA * 16 + fq * 4 + j; if (ct == 0) dsum[(wave & 1) * 64 + t] = rs[j]; else dsum[(wave & 1) * 64 + t] += rs[j]; } }
                LDS_WAIT();
            }
            { const int t = tid >> 3, k8 = (tid & 7) * 8; float f[8]; unpack8(*(const LAS u32x4*)(Qs + t * PT + k8), f); float s = 0.f;
#pragma unroll
              for (int e = 0; e < 8; ++e) s += f[e] * nvec[k8 + e];
              s = row8_sum(s);
              if ((tid & 7) == 0) nq[t] = s; }
        }
        __syncthreads();
        {
            const int row0 = chain_row(b, dir, ci * 64), sgn = dir ? -1 : 1;
#pragma unroll
            for (int ct = 0; ct < 2; ++ct) { const int vt = tB0 + ct; f32x4 a1 = {0.f, 0.f, 0.f, 0.f}, a2 = {0.f, 0.f, 0.f, 0.f};
#pragma unroll
                for (int kk = 0; kk < 2; ++kk) { const bf16x8 sa = *(const LAS bf16x8*)(Ss + (tA * 16 + fr) * PT + kk * 32 + fq * 8); const bf16x8 vb = *(const LAS bf16x8*)(Vt + (vt * 16 + fr) * PT + kk * 32 + fq * 8);
                    a1 = __builtin_amdgcn_mfma_f32_16x16x32_bf16(sa, vb, a1, 0, 0, 0);
                    const bf16x8 qa = *(const LAS bf16x8*)(Qs + (tA * 16 + fr) * PT + kk * 32 + fq * 8); const bf16x8 cb = *(const LAS bf16x8*)(Cs + (vt * 16 + fr) * PT + kk * 32 + fq * 8);
                    a2 = __builtin_amdgcn_mfma_f32_16x16x32_bf16(qa, cb, a2, 0, 0, 0); }
#pragma unroll
                for (int j = 0; j < 4; ++j) { const int t = tA * 16 + fq * 4 + j; const float wi = wint[t];
                    const float den = dsum[t] + dsum[64 + t] + wi * nq[t]; const float hv = (a1[j] + wi * a2[j]) / fmaxf(fabsf(den), emt[t]);
                    YM[(size_t)(row0 + sgn * t) * 256 + h * 64 + vt * 16 + fr] = (bf16_t)f2bf(hv); } }
        }
        {
            const float dec = scal[1];
#pragma unroll
            for (int ct = 0; ct < 2; ++ct) { const int kt = tB0 + ct; f32x4 acc = accC[ct] * dec;
#pragma unroll
                for (int kk = 0; kk < 2; ++kk) { float f[8]; unpack8(*(const LAS u32x4*)(Vt + (tA * 16 + fr) * PT + kk * 32 + fq * 8), f);
                    const f32x4 g0 = *(const LAS f32x4*)(gw + kk * 32 + fq * 8), g1 = *(const LAS f32x4*)(gw + kk * 32 + fq * 8 + 4);
                    f[0] *= g0[0]; f[1] *= g0[1]; f[2] *= g0[2]; f[3] *= g0[3]; f[4] *= g1[0]; f[5] *= g1[1]; f[6] *= g1[2]; f[7] *= g1[3];
                    const u32x4 pa = pack8(f); const bf16x8 a = __builtin_bit_cast(bf16x8, pa);
                    const bf16x8 kb = *(const LAS bf16x8*)(Kt + (kt * 16 + fr) * PT + kk * 32 + fq * 8);
                    acc = __builtin_amdgcn_mfma_f32_16x16x32_bf16(a, kb, acc, 0, 0, 0); }
                accC[ct] = acc; }
        }
        __syncthreads();
        {
            const float dec = scal[1];
            if (tid < 64) { float s = 0.f;
                for (int sI = 0; sI < 64; ++sI) s += gw[sI] * bf2f(Ks[sI * PT + tid]);
                nvec[tid] = dec * nvec[tid] + s; }
#pragma unroll
            for (int ct = 0; ct < 2; ++ct) { const int kt = tB0 + ct;
#pragma unroll
                for (int j = 0; j < 4; ++j) Cs[(tA * 16 + fq * 4 + j) * PT + kt * 16 + fr] = (bf16_t)f2bf(accC[ct][j]); }
        }
    }
    __syncthreads();
}

__device__ __forceinline__ void attn_unit(const Params& p, int l, int u, LAS unsigned char* lds) {
    const int tid = opaque_tid(), wave = tid >> 6, lane = tid & 63, fr = lane & 15, fq = lane >> 4;
    constexpr int PT = 72;
    LAS bf16_t* Ks = (LAS bf16_t*)lds; LAS bf16_t* Vt = Ks + 64 * PT;
    const bf16_t* P2 = (const bf16_t*)(p.ws + WS_P2); bf16_t* Y = (bf16_t*)(p.ws + WS_P1);
    const float* ROPE = (const float*)(p.ws + WS_ROPE);
    int b, kvh, gp, qb, qrow0; bool lat;
    if (u < 1024) { lat = true; gp = u & 1; qb = (u >> 1) & 15; kvh = (u >> 5) & 1; b = u >> 6; qrow0 = MC + b * SEQ + qb * 128; }
    else { const int w = u - 1024; lat = false; gp = w & 1; qb = (w >> 1) & 1; kvh = (w >> 2) & 1; b = w >> 3; qrow0 = b * TC + qb * 128; }
    const int g = gp * 2 + (wave >> 2), head = kvh * 4 + g, qi0 = (wave & 3) * 32;
    constexpr float LOG2E = 1.4426950408889634f;
    bf16x8 Qf[2][2];
#pragma unroll
    for (int mt = 0; mt < 2; ++mt) { const int qi = qi0 + mt * 16 + fr; const bf16_t* qp = P2 + (size_t)(qrow0 + qi) * P2W + head * 64 + fq * 8;
        float a[8], c[8]; unpack8(*(const u32x4*)qp, a); unpack8(*(const u32x4*)(qp + 32), c);
        if (lat) { const float* rp = ROPE + ((size_t)(qb * 128 + qi) * 32 + fq * 8) * 2;
#pragma unroll
            for (int e = 0; e < 8; ++e) { const float cs = rp[2 * e], sn = rp[2 * e + 1]; const float u1 = a[e], u2 = c[e]; a[e] = u1 * cs - u2 * sn; c[e] = u1 * sn + u2 * cs; } }
#pragma unroll
        for (int e = 0; e < 8; ++e) { a[e] *= 0.125f * LOG2E; c[e] *= 0.125f * LOG2E; }
        const u32x4 pa = pack8(a), pc = pack8(c); Qf[mt][0] = __builtin_bit_cast(bf16x8, pa); Qf[mt][1] = __builtin_bit_cast(bf16x8, pc); }
    const float sink = p.in[I_SINK][l * 8 + head] * LOG2E;
    float mrun[2] = {sink, sink}, lrun[2] = {fq == 0 ? 1.f : 0.f, fq == 0 ? 1.f : 0.f};
    f32x4 O[2][4];
#pragma unroll
    for (int mt = 0; mt < 2; ++mt)
#pragma unroll
        for (int dt = 0; dt < 4; ++dt) O[mt][dt] = (f32x4){0.f, 0.f, 0.f, 0.f};
    const int bt_lo = lat ? (qb == 0 ? 2 : 0) : 0, nband = lat ? ((qb == 15 ? 4 : 6) - bt_lo) : 0, ntiles = 4 + nband;
    const int skey = tid >> 3, sg = tid & 7;
    u32x2 kl, kh; u32x4 vr;
#define ATT_TILE_ROW(i) ((i) < 4 ? b * TC + (i) * 64 : MC + b * SEQ + qb * 128 - 128 + ((i) - 4 + bt_lo) * 64)
    { const int krow0 = ATT_TILE_ROW(0); const bf16_t* kp = P2 + (size_t)(krow0 + skey) * P2W + 512 + kvh * 64;
      kl = *(const u32x2*)(kp + sg * 4); kh = *(const u32x2*)(kp + 32 + sg * 4); vr = *(const u32x4*)(kp + 128 + sg * 8); }
    for (int i = 0; i < ntiles; ++i) {
        const bool band = i >= 4; const int kpos0 = band ? qb * 128 - 128 + (i - 4 + bt_lo) * 64 : 0;
        __syncthreads();
        { u32x2 lo = kl, hi = kh;
          if (band) { const float* rp = ROPE + ((size_t)(kpos0 + skey) * 32 + sg * 4) * 2; const f32x4 r0 = *(const f32x4*)rp, r1 = *(const f32x4*)(rp + 4);
              const float a0 = bflo(lo.x), a1 = bfhi(lo.x), a2 = bflo(lo.y), a3 = bfhi(lo.y), c0 = bflo(hi.x), c1 = bfhi(hi.x), c2 = bflo(hi.y), c3 = bfhi(hi.y);
              lo.x = pk2(a0 * r0[0] - c0 * r0[1], a1 * r0[2] - c1 * r0[3]); lo.y = pk2(a2 * r1[0] - c2 * r1[1], a3 * r1[2] - c3 * r1[3]);
              hi.x = pk2(a0 * r0[1] + c0 * r0[0], a1 * r0[3] + c1 * r0[2]); hi.y = pk2(a2 * r1[1] + c2 * r1[0], a3 * r1[3] + c3 * r1[2]); }
          *(LAS u32x2*)(Ks + skey * PT + sg * 4) = lo; *(LAS u32x2*)(Ks + skey * PT + 32 + sg * 4) = hi;
          const int d0 = sg * 8;
          Vt[(d0 + 0) * PT + skey] = (bf16_t)(vr.x & 0xffffu); Vt[(d0 + 1) * PT + skey] = (bf16_t)(vr.x >> 16); Vt[(d0 + 2) * PT + skey] = (bf16_t)(vr.y & 0xffffu); Vt[(d0 + 3) * PT + skey] = (bf16_t)(vr.y >> 16);
          Vt[(d0 + 4) * PT + skey] = (bf16_t)(vr.z & 0xffffu); Vt[(d0 + 5) * PT + skey] = (bf16_t)(vr.z >> 16); Vt[(d0 + 6) * PT + skey] = (bf16_t)(vr.w & 0xffffu); Vt[(d0 + 7) * PT + skey] = (bf16_t)(vr.w >> 16); }
        __syncthreads();
        if (i + 1 < ntiles) { const int krow0 = ATT_TILE_ROW(i + 1); const bf16_t* kp = P2 + (size_t)(krow0 + skey) * P2W + 512 + kvh * 64;
            kl = *(const u32x2*)(kp + sg * 4); kh = *(const u32x2*)(kp + 32 + sg * 4); vr = *(const u32x4*)(kp + 128 + sg * 8); }
        bool needmask = false;
        if (band) { const int qbase = qb * 128 + qi0; const int dmin = kpos0 - (qbase + 31), dmax = kpos0 + 63 - qbase;
            if (dmin > 128 || dmax < -128) continue;
            needmask = (dmax > 128 || dmin < -128); }
        f32x4 Sx[2][4];
#pragma unroll
        for (int nt = 0; nt < 4; ++nt) { const bf16x8 k0 = *(const LAS bf16x8*)(Ks + (nt * 16 + fr) * PT + fq * 8), k1 = *(const LAS bf16x8*)(Ks + (nt * 16 + fr) * PT + 32 + fq * 8);
#pragma unroll
            for (int mt = 0; mt < 2; ++mt) { f32x4 acc = {0.f, 0.f, 0.f, 0.f};
                acc = __builtin_amdgcn_mfma_f32_16x16x32_bf16(k0, Qf[mt][0], acc, 0, 0, 0); acc = __builtin_amdgcn_mfma_f32_16x16x32_bf16(k1, Qf[mt][1], acc, 0, 0, 0); Sx[mt][nt] = acc; } }
        bf16x8 Pf[2][2];
#pragma unroll
        for (int mt = 0; mt < 2; ++mt) {
            if (needmask) { const int qp = qb * 128 + qi0 + mt * 16 + fr;
#pragma unroll
                for (int nt = 0; nt < 4; ++nt)
#pragma unroll
                    for (int j = 0; j < 4; ++j) { const int dlt = kpos0 + nt * 16 + 4 * fq + j - qp; if (dlt > 128 || dlt < -128) Sx[mt][nt][j] = -1e30f; } }
            float mx = mrun[mt];
#pragma unroll
            for (int nt = 0; nt < 4; ++nt) mx = fmaxf(fmaxf(mx, fmaxf(Sx[mt][nt][0], Sx[mt][nt][1])), fmaxf(Sx[mt][nt][2], Sx[mt][nt][3]));
            mx = fmaxf(mx, __shfl_xor(mx, 16)); mx = fmaxf(mx, __shfl_xor(mx, 32));
            const float alpha = __builtin_amdgcn_exp2f(mrun[mt] - mx); mrun[mt] = mx; float ls = 0.f;
#pragma unroll
            for (int nt = 0; nt < 4; ++nt)
#pragma unroll
                for (int j = 0; j < 4; ++j) { const float e = __builtin_amdgcn_exp2f(Sx[mt][nt][j] - mx); Sx[mt][nt][j] = e; ls += e; }
            lrun[mt] = lrun[mt] * alpha + ls;
#pragma unroll
            for (int dt = 0; dt < 4; ++dt) O[mt][dt] = O[mt][dt] * alpha;
#pragma unroll
            for (int kk = 0; kk < 2; ++kk) { u32x4 pw; pw.x = pk2(Sx[mt][2 * kk][0], Sx[mt][2 * kk][1]); pw.y = pk2(Sx[mt][2 * kk][2], Sx[mt][2 * kk][3]);
                pw.z = pk2(Sx[mt][2 * kk + 1][0], Sx[mt][2 * kk + 1][1]); pw.w = pk2(Sx[mt][2 * kk + 1][2], Sx[mt][2 * kk + 1][3]); Pf[mt][kk] = __builtin_bit_cast(bf16x8, pw); }
        }
#pragma unroll
        for (int dt = 0; dt < 4; ++dt)
#pragma unroll
            for (int kk = 0; kk < 2; ++kk) { const u32x2 va = *(const LAS u32x2*)(Vt + (dt * 16 + fr) * PT + kk * 32 + 4 * fq), vb = *(const LAS u32x2*)(Vt + (dt * 16 + fr) * PT + kk * 32 + 16 + 4 * fq);
                const u32x4 vw = {va.x, va.y, vb.x, vb.y}; const bf16x8 vf = __builtin_bit_cast(bf16x8, vw);
#pragma unroll
                for (int mt = 0; mt < 2; ++mt) O[mt][dt] = __builtin_amdgcn_mfma_f32_16x16x32_bf16(vf, Pf[mt][kk], O[mt][dt], 0, 0, 0); }
    }
#undef ATT_TILE_ROW
#pragma unroll
    for (int mt = 0; mt < 2; ++mt) { float ls = lrun[mt]; ls += __shfl_xor(ls, 16); ls += __shfl_xor(ls, 32); const float il = 1.f / ls;
        bf16_t* yp = Y + (size_t)(qrow0 + qi0 + mt * 16 + fr) * D + 256 + head * 64 + 4 * fq;
#pragma unroll
        for (int dt = 0; dt < 4; ++dt) { const f32x4 o = O[mt][dt] * il; u32x2 w; w.x = pk2(o[0], o[1]); w.y = pk2(o[2], o[3]); *(u32x2*)(yp + dt * 16) = w; } }
    __syncthreads();
}

__device__ __forceinline__ void phase_post(const Params& p, int l, int row_lo, int bid, int G) {
    const int tid = opaque_tid(), wave = tid >> 6, lane = tid & 63, c = 4 * lane;
    const float* YR = (const float*)(p.ws + WS_H); const bf16_t* YM = (const bf16_t*)(p.ws + WS_YM); const bf16_t* RKV = (const bf16_t*)(p.ws + WS_RKV);
    const bf16_t* Gb = (const bf16_t*)(p.ws + WS_G); const bf16_t* P2 = (const bf16_t*)(p.ws + WS_P2); bf16_t* Y = (bf16_t*)(p.ws + WS_P1);
    const f32x4 lnw = *(const f32x4*)(p.in[I_RLNW] + l * 256 + c), lnb = *(const f32x4*)(p.in[I_RLNB] + l * 256 + c), rk_ = *(const f32x4*)(p.in[I_RRK] + l * 256 + c),
                ng = *(const f32x4*)(p.in[I_MNG] + l * 256 + c);
    for (int row0 = row_lo + bid * 8 + wave; row0 < M; row0 += G * 16) {
        int rows[2]; rows[0] = row0; rows[1] = row0 + G * 8 < M ? row0 + G * 8 : row0;
        f32x4 ya[2], yb[2]; u32x2 rw[2], kw[2], vw[2], gw_[2], h0[2], h1[2], ow[2];
#pragma unroll
        for (int i = 0; i < 2; ++i) { const size_t row = (size_t)rows[i];
            ya[i] = *(const f32x4*)(YR + row * 256 + c); yb[i] = *(const f32x4*)(YR + ((size_t)M + row) * 256 + c);
            rw[i] = *(const u32x2*)(RKV + row * 768 + c); kw[i] = *(const u32x2*)(RKV + row * 768 + 256 + c); vw[i] = *(const u32x2*)(RKV + row * 768 + 512 + c);
            gw_[i] = *(const u32x2*)(Gb + row * 256 + c); h0[i] = *(const u32x2*)(YM + row * 256 + c); h1[i] = *(const u32x2*)(YM + ((size_t)M + row) * 256 + c);
            ow[i] = *(const u32x2*)(P2 + row * P2W + 1536 + c); }
        u32x2 wr_[2], wm_[2];
#pragma unroll
        for (int i = 0; i < 2; ++i) {
            { f32x4 y = ya[i] + yb[i];
              float s = y[0] + y[1] + y[2] + y[3]; s = row16_sum(s); const float mu = s * (1.f / 64.f);
              y = y - mu; float q = y[0] * y[0] + y[1] * y[1] + y[2] * y[2] + y[3] * y[3]; q = row16_sum(q);
              const float rs = rsqrtf(q * (1.f / 64.f) + 64e-5f);
              const float r[4] = {bflo(rw[i].x), bfhi(rw[i].x), bflo(rw[i].y), bfhi(rw[i].y)}, k[4] = {bflo(kw[i].x), bfhi(kw[i].x), bflo(kw[i].y), bfhi(kw[i].y)},
                          v[4] = {bflo(vw[i].x), bfhi(vw[i].x), bflo(vw[i].y), bfhi(vw[i].y)}, g[4] = {bflo(gw_[i].x), bfhi(gw_[i].x), bflo(gw_[i].y), bfhi(gw_[i].y)};
              float bs = r[0] * k[0] * rk_[0] + r[1] * k[1] * rk_[1] + r[2] * k[2] * rk_[2] + r[3] * k[3] * rk_[3];
              bs = row16_sum(bs);
              float o[4];
#pragma unroll
              for (int e = 0; e < 4; ++e) o[e] = (y[e] * rs * lnw[e] + lnb[e] + bs * v[e]) * g[e];
              wr_[i].x = pk2(o[0], o[1]); wr_[i].y = pk2(o[2], o[3]); }
            { f32x4 y = {bflo(h0[i].x) + bflo(h1[i].x), bfhi(h0[i].x) + bfhi(h1[i].x), bflo(h0[i].y) + bflo(h1[i].y), bfhi(h0[i].y) + bfhi(h1[i].y)};
              float s = y[0] + y[1] + y[2] + y[3]; s = row16_sum(s); const float mu = s * (1.f / 64.f);
              y = y - mu; float q = y[0] * y[0] + y[1] * y[1] + y[2] * y[2] + y[3] * y[3]; q = row16_sum(q);
              const float rs = rsqrtf(q * (1.f / 64.f) + 1e-6f);
              const float og[4] = {bflo(ow[i].x), bfhi(ow[i].x), bflo(ow[i].y), bfhi(ow[i].y)};
              float o[4];
#pragma unroll
              for (int e = 0; e < 4; ++e) o[e] = sigmoidf_(og[e]) * (y[e] * rs * ng[e]);
              wm_[i].x = pk2(o[0], o[1]); wm_[i].y = pk2(o[2], o[3]); }
        }
#pragma unroll
        for (int i = 0; i < 2; ++i) { *(u32x2*)(Y + (size_t)rows[i] * D + c) = wr_[i]; *(u32x2*)(Y + (size_t)rows[i] * D + 768 + c) = wm_[i]; }
    }
}

__device__ __forceinline__ void weights_work(const Params& p, int l, LAS unsigned char* lds, int it_lo, int it_hi, bool extras, int bi, int nb) {
    if (bi >= 0 && bi < nb) {
        const int ncb = (extras && nb > 222) ? nb - 111 : nb;
        convert_weights(p, l, lds, it_lo, it_hi, bi, ncb);
        if (extras) { convert_lora(p, l, bi, nb); phase_cvec(p, l, lds, bi, nb); }
    }
}
#define XB_TMO      128
#define XB_XCNT(j)  (256  + 64 * (j))
#define XB_XSUB(j)  (1280 + 64 * (j))
#define XB_XGEN(j)  (2304 + 64 * (j))
#define XB_TOP      3328
#define XB_TOPGEN   3392
#define XCD_BAR_WORDS 3456
#define XB_SPIN_CAP (1u << 18)

__device__ __forceinline__ unsigned xb_ld(unsigned* p)              { return __hip_atomic_load(p, __ATOMIC_RELAXED, __HIP_MEMORY_SCOPE_AGENT); }
__device__ __forceinline__ unsigned xb_add(unsigned* p, unsigned v) { return __hip_atomic_fetch_add(p, v, __ATOMIC_RELAXED, __HIP_MEMORY_SCOPE_AGENT); }
__device__ __forceinline__ unsigned xb_xcc_id() { return (unsigned)__builtin_amdgcn_s_getreg((3 << 11) | 20) & 0xFu; }
#define XB_SPIN(cond, bar) do { unsigned _sp = 0; while (cond) { __builtin_amdgcn_s_sleep(1); \
    if ((++_sp & 255u) == 0u) { if (xb_ld(&(bar)[XB_TMO])) break; if (_sp > XB_SPIN_CAP) { atomicAdd(&(bar)[XB_TMO], 1u); break; } } } } while (0)

struct XcdBarrier {
    unsigned* bar; unsigned x;
    volatile LAS unsigned* st;
};

__device__ __forceinline__ XcdBarrier xcd_barrier_post(unsigned* bar, volatile LAS unsigned* st) {
    XcdBarrier b; b.bar = bar; b.x = xb_xcc_id(); b.st = st;
    if (threadIdx.x == 0) (void)xb_add(&bar[XB_XCNT(b.x)], 1u);
    return b;
}
__device__ __forceinline__ void xcd_barrier_complete(unsigned* bar, unsigned x, unsigned& nloc, unsigned& nx) {
    const unsigned G = gridDim.x * gridDim.y * gridDim.z;
    unsigned sum, cnt, mine, sp = 0u;
    for (;;) {
        sum = 0u; cnt = 0u; mine = 0u;
#pragma unroll
        for (unsigned j = 0; j < 16; ++j) { const unsigned c = xb_ld(&bar[XB_XCNT(j)]); sum += c; cnt += (c > 0u) ? 1u : 0u; mine = (j == x) ? c : mine; }
        if (sum == G) break;
        __builtin_amdgcn_s_sleep(1);
        if ((++sp & 255u) == 0u) { if (xb_ld(&bar[XB_TMO])) break; if (sp > XB_SPIN_CAP) { atomicAdd(&bar[XB_TMO], 1u); break; } }
    }
    nloc = mine > 0u ? mine : 1u; nx = cnt > 0u ? cnt : 1u;
}

__device__ __forceinline__ void xcd_barrier(const XcdBarrier& b) {
    asm volatile("s_waitcnt vmcnt(0)" ::: "memory");
    __syncthreads();
    if (threadIdx.x == 0) {
        unsigned* bar = b.bar;
        __builtin_amdgcn_s_waitcnt(0);
        unsigned nloc = b.st[0], nx = b.st[1];
        if (nloc == 0u) { xcd_barrier_complete(bar, b.x, nloc, nx); b.st[0] = nloc; b.st[1] = nx; }
        const unsigned old = xb_add(&bar[XB_XSUB(b.x)], 1u);
        const unsigned gen = old / nloc;
        if (old + 1u == (gen + 1u) * nloc) {
            __builtin_amdgcn_fence(__ATOMIC_RELEASE, "agent");
            asm volatile("s_waitcnt vmcnt(0)" ::: "memory");
            const unsigned og = xb_add(&bar[XB_TOP], 1u);
            const unsigned tg = og / nx;
            if (og + 1u == (tg + 1u) * nx) xb_add(&bar[XB_TOPGEN], 1u);
            else XB_SPIN(xb_ld(&bar[XB_TOPGEN]) == tg, bar);
            __builtin_amdgcn_fence(__ATOMIC_ACQUIRE, "agent");
            xb_add(&bar[XB_XGEN(b.x)], 1u);
            asm volatile("s_waitcnt vmcnt(0)" ::: "memory");
        } else {
            XB_SPIN(xb_ld(&bar[XB_XGEN(b.x)]) == gen, bar);
            __builtin_amdgcn_fence(__ATOMIC_ACQUIRE, "agent");
            asm volatile("s_waitcnt vmcnt(0)" ::: "memory");
        }
    }
    __syncthreads();
}

constexpr int N_PHASES = 2 + 8 * DEPTH;
__global__ void __launch_bounds__(NT, 2) fwd_megakernel(Params p) {
    extern __shared__ __attribute__((aligned(16))) unsigned char lds_raw[];
    LAS unsigned char* lds = (LAS unsigned char*)lds_raw;
    cg::grid_group grid = cg::this_grid();
    { volatile LAS unsigned* stz = (volatile LAS unsigned*)(lds + LDS_BYTES - 48); if (threadIdx.x < 4) stz[threadIdx.x] = 0u; }
    __syncthreads();
    XcdBarrier xbar = xcd_barrier_post((unsigned*)(p.ws + WS_BAR), (volatile LAS unsigned*)(lds + LDS_BYTES - 48));
#ifndef DUPM
#define DUPM 0
#endif
    for (int ph = p.ph_lo; ph < p.ph_hi; ++ph) {
      const int nrep = (DUPM && ph >= 1 && ph < N_PHASES - 1 && ((DUPM >> ((ph - 1) % 8)) & 1)) ? 2 : 1;
      for (int rep = 0; rep < nrep; ++rep) {
        int bid = blockIdx.x, G = gridDim.x; asm volatile("" : "+s"(bid), "+s"(G));
        bool skip_bar = false;
        float* Xc = (float*)(p.ws + WS_XC);
#ifndef PHM
#define PHM 0xffff
#endif
        if (ph == 0) { if (PHM & 1) phase_adaln(p, lds, bid, G); }
        else if (ph == N_PHASES - 1) { if (PHM & 2) phase_final(p, bid, G); }
        else {
            const int l = (ph - 1) / 8, s = (ph - 1) % 8; const bool last = (l == DEPTH - 1);
            const int row_lo = last ? MC : 0;
            const float* modl = (const float*)(p.ws + WS_MOD) + (size_t)l * 17 * 6144;
            int w_l = -1, w_lo = 0, w_hi = 0, w_bi = 0, w_nb = 0; bool w_ex = false;
            const bool pre = (G == 256);
            if (s == 0) { if (pre && l > 0) skip_bar = true;
                else { w_l = l; w_bi = bid; w_nb = G; w_lo = 0; w_hi = CW_ITOT; w_ex = true; } }
            else if (s == 1) { if (PHM & 16) { pg8::Gemm g{(const pg8::bf16_t*)(p.ws + WS_H), (const pg8::bf16_t*)(p.ws + WS_WIN), M, NINP, D}; pg8::StaticOrder S; S.init(M, NINP, G, bid);
                EpiIn E{(bf16_t*)(p.ws + WS_P1), (bf16_t*)(p.ws + WS_P2), (const float*)(p.ws + WS_RSQ1), (const float*)(p.ws + WS_CV1)}; pg8::gemm_phase<EpiIn, pg8::StaticOrder, true, true>(lds, g, S, E); }
                if (pre && l > 0) { w_l = l; w_lo = CW_I123; w_hi = CW_ITOT; w_ex = false; w_bi = bid - 192; w_nb = 64; } }
            else if (s == 2) { if (PHM & 32) phase_prep(p, l, lds, bid, G); }
            else if (s == 3) {
                const int natt = last ? 1024 : 1152;
                unsigned* qctr = (unsigned*)(p.ws + WS_CTR) + l * 64;
                LAS int* qslot = (LAS int*)(lds + LDS_BYTES - 64);
                for (int c = bid; c < 256; c += G) {
                    if (c < 128) { if (PHM & 64) rwkv_chain(p, l, c, lds); }
                    else { if (PHM & 128) mlstm_chain(p, l, c - 128, lds); } }
                for (;;) {
                    if (opaque_tid() == 0) *qslot = (int)__hip_atomic_fetch_add(qctr, 1u, __ATOMIC_RELAXED, __HIP_MEMORY_SCOPE_AGENT);
                    __syncthreads();
                    const int u = *qslot;
                    __syncthreads();
                    if (u >= natt) break;
                    if (PHM & 256) attn_unit(p, l, u, lds);
                }
            }
            else if (s == 4) { phase_post(p, l, row_lo, bid, G); }
            else if (s == 5) { if (PHM & 2048) { const int Mg = M - row_lo; pg8::Gemm g{(const pg8::bf16_t*)(p.ws + WS_P1) + (size_t)row_lo * D, (const pg8::bf16_t*)(p.ws + WS_WOUT), Mg, D, D}; pg8::StaticOrder S; S.init(Mg, D, G, bid);
                EpiRes E{Xc, p.out, modl, 2, row_lo, (bf16_t*)(p.ws + WS_H), (float*)(p.ws + WS_RSQ2), p.in[I_N2G] + l * D, modl, 4}; pg8::gemm_phase<EpiRes, pg8::StaticOrder, true, true>(lds, g, S, E); } }
            else if (s == 6) { if (PHM & 8192) { const int Mg = M - row_lo; pg8::Gemm g{(const pg8::bf16_t*)(p.ws + WS_H) + (size_t)row_lo * D, (const pg8::bf16_t*)(p.ws + WS_W1), Mg, DFF, D}; pg8::StaticOrder S; S.init(Mg, DFF, G, bid);
                EpiSq E{(bf16_t*)(p.ws + WS_P1) + (size_t)row_lo * DFF, (const float*)(p.ws + WS_RSQ2), (const float*)(p.ws + WS_CV2), row_lo}; pg8::gemm_phase<EpiSq, pg8::StaticOrder, true, true>(lds, g, S, E); } }
            else if (PHM & 16384) { const int Mg = M - row_lo; pg8::Gemm g{(const pg8::bf16_t*)(p.ws + WS_P1) + (size_t)row_lo * DFF, (const pg8::bf16_t*)(p.ws + WS_W2), Mg, D, DFF}; pg8::StaticOrder S; S.init(Mg, D, G, bid);
                EpiRes E{Xc, p.out, modl, 5, row_lo, (bf16_t*)(p.ws + WS_H), (float*)(p.ws + WS_RSQ1), p.in[I_N1G] + (last ? l : l + 1) * D, last ? modl : modl + 17 * 6144, 1}; pg8::gemm_phase<EpiRes, pg8::StaticOrder, true, true>(lds, g, S, E);
                if (pre && !last) { w_l = l + 1; w_lo = 0; w_hi = CW_I123; w_ex = true; w_bi = bid - 64; w_nb = 192; } }
            if (w_l >= 0) weights_work(p, w_l, lds, w_lo, w_hi, w_ex, w_bi, w_nb);
            if (s == 0 && l == 0) phase_boot(p, bid, G);
        }
        if ((ph + 1 < p.ph_hi || rep + 1 < nrep) && !skip_bar) { if (ph == 0) grid.sync(); else xcd_barrier(xbar); }
      }
    }
}

#ifndef MK_ONE_LAUNCH
#define MK_ONE_LAUNCH 1
#endif
extern "C" void kernel_launch(void* const* d_in, const int* in_sizes, int n_in, void* d_out, int out_size, void* d_ws, size_t ws_size, hipStream_t stream) {
    static int grid = 0;
    if (grid == 0) {
        if (n_in != 29 || out_size != ML * D || ws_size < WS_END) { fprintf(stderr, "kernel_launch: unexpected shapes: n_in %d out %d ws %zu (need %zu)\n", n_in, out_size, ws_size, (size_t)WS_END); grid = -1; return; }
        int dev = 0, cus = 0, per_cu = 0;
        hipGetDevice(&dev); hipDeviceGetAttribute(&cus, hipDeviceAttributeMultiprocessorCount, dev);
        if (hipFuncSetAttribute((const void*)fwd_megakernel, hipFuncAttributeMaxDynamicSharedMemorySize, LDS_BYTES) != hipSuccess) { fprintf(stderr, "kernel_launch: hipFuncSetAttribute failed\n"); grid = -1; return; }
        if (hipOccupancyMaxActiveBlocksPerMultiprocessor(&per_cu, (const void*)fwd_megakernel, NT, LDS_BYTES) != hipSuccess || per_cu < 1) { fprintf(stderr, "kernel_launch: occupancy query says %d\n", per_cu); per_cu = 1; }
        (void)hipGetLastError();
        grid = cus * per_cu;
        fprintf(stderr, "kernel_launch: grid %d (cus %d x %d)\n", grid, cus, per_cu);
    }
    if (grid < 0) return;
    Params p{};
    for (int i = 0; i < 29; ++i) p.in[i] = (const float*)d_in[i];
    p.out = (float*)d_out; p.ws = (unsigned char*)d_ws;
#if MK_ONE_LAUNCH
    p.ph_lo = 0; p.ph_hi = N_PHASES;
    (void)hipMemsetAsync((char*)d_ws + WS_CTR, 0, 4096 + 16384, stream);
    { void* args[] = {&p}; hipError_t e = hipLaunchCooperativeKernel((const void*)fwd_megakernel, dim3(grid), dim3(NT), args, LDS_BYTES, stream);
      if (e != hipSuccess) fprintf(stderr, "cooperative launch failed: %s (grid %d)\n", hipGetErrorString(e), grid); }
#else
    for (int ph = 0; ph < N_PHASES; ++ph) { p.ph_lo = ph; p.ph_hi = ph + 1; hipLaunchKernelGGL(fwd_megakernel, dim3(grid), dim3(NT), LDS_BYTES, stream, p); }
#endif
}
```
